# Optimizing an MI355X kernel written in HIP

```python
import math
import jax, jax.numpy as jnp
from jax import lax
import numpy as np

D_MODEL = 1024
BATCH = 16
SEQ = 256
DEPTH = 4
DEC_BATCH = 2
DEC_SEQ = 2048
PAST_LEN = 256

GRID_W = 64
N_MIXERS = 3
N_A = (DEPTH + 2) // 3
N_B = (DEPTH + 1) // 3
N_C = DEPTH // 3
N_MOD = 9
D_FF = ((8 * D_MODEL // 3 + 127) // 128) * 128
EPS = 1e-6
H_A = D_MODEL // 128
DK_A = 128
DV_A = 128
INNER_A = H_A * DV_A
CONV_K = 5
CHUNK = 64
H_B = D_MODEL // 128
DH_B = 64
Q_BLOCK = 128
ROPE_BASE = 10000.0
POOL_WINDOWS = (2, 4, 8, 16)
POOL_GW = D_MODEL // 4

kernel_name = 'hybrid_diffusion_prefix_trunk_step'

F32 = jnp.float32


def _rms(x, g):
    xf = x.astype(F32)
    y = xf * lax.rsqrt(jnp.mean(xf * xf, axis=-1, keepdims=True) + EPS) * g.astype(F32)
    return y.astype(x.dtype)


def _l2(x):
    xf = x.astype(F32)
    return xf * lax.rsqrt(jnp.sum(xf * xf, axis=-1, keepdims=True) + EPS)


def _modulation(cond, w, b):
    m = jax.nn.silu(cond) @ w + b
    return m.reshape(cond.shape[0], 1, N_MOD, D_MODEL)


def _adanorm(x, g, shift, scale):
    return _rms(x, g) * (1.0 + scale) + shift


def _half_ffn(x, m, j0, g, wg, wu, wd):
    h = _adanorm(x, g, m[:, :, j0], m[:, :, j0 + 1])
    f = (jax.nn.silu(h @ wg) * (h @ wu)) @ wd
    return x + 0.5 * m[:, :, j0 + 2] * f


def _dwconv_centred(x, w):
    k, ch = w.shape
    return lax.conv_general_dilated(x, w[:, None, :].astype(x.dtype), window_strides=(1,),
                                    padding=[(k // 2, k // 2)],
                                    dimension_numbers=('NWC', 'WIO', 'NWC'),
                                    feature_group_count=ch)


def _chunk_gated_delta(q, k, v, g, beta, s0):
    b, l, h, dk = q.shape
    dv = v.shape[-1]
    n = l // CHUNK
    ch = lambda t: t.reshape(b, n, CHUNK, h, t.shape[-1]).transpose(1, 0, 3, 2, 4)
    cg = lambda t: t.reshape(b, n, CHUNK, h).transpose(1, 0, 3, 2)
    q, k, v = ch(q) * (dk ** -0.5), ch(k), ch(v)
    gcum = jnp.cumsum(cg(g), axis=-1)
    beta = cg(beta)
    idx = jnp.arange(CHUNK)
    incl = idx[:, None] >= idx[None, :]
    strict = idx[:, None] > idx[None, :]
    diff = gcum[..., :, None] - gcum[..., None, :]
    decay = jnp.where(incl, jnp.exp(jnp.where(incl, diff, 0.0)), 0.0)
    kb = k * beta[..., None]
    lmat = jnp.where(strict, jnp.einsum('nbhid,nbhjd->nbhij', kb, k) * decay, 0.0)
    amat = lmat + jnp.eye(CHUNK, dtype=F32)
    rhs = jnp.concatenate([v * beta[..., None], kb * jnp.exp(gcum)[..., None]], axis=-1)
    sol = lax.linalg.triangular_solve(amat, rhs, left_side=True, lower=True, unit_diagonal=True)
    u, w = sol[..., :dv], sol[..., dv:]
    attn = jnp.einsum('nbhid,nbhjd->nbhij', q, k) * decay
    qg = q * jnp.exp(gcum)[..., None]
    kd = k * jnp.exp(gcum[..., -1:] - gcum)[..., None]
    glast = jnp.exp(gcum[..., -1])

    def step(s, xs):
        u_i, w_i, attn_i, qg_i, kd_i, gl_i = xs
        v_new = u_i - jnp.einsum('bhcd,bhde->bhce', w_i, s)
        o = jnp.einsum('bhcd,bhde->bhce', qg_i, s) + jnp.einsum('bhij,bhje->bhie', attn_i, v_new)
        s = s * gl_i[..., None, None] + jnp.einsum('bhcd,bhce->bhde', kd_i, v_new)
        return s, o

    s_fin, o = lax.scan(step, s0, (u, w, attn, qg, kd, glast))
    o = o.transpose(1, 0, 3, 2, 4).reshape(b, l, h, dv)
    return o, s_fin


def _gated_deltanet(h, w_in, conv_w, a_log, dt_bias, norm_g, w_out, s0_f, s0_b):
    b, l, _ = h.shape
    proj = h @ w_in
    qkv = jax.nn.silu(_dwconv_centred(proj[..., :3 * INNER_A], conv_w))
    z = proj[..., 3 * INNER_A:4 * INNER_A].reshape(b, l, H_A, DV_A)
    ab = proj[..., 4 * INNER_A:].astype(F32).reshape(b, l, 2, 2, H_A)
    q = _l2(qkv[..., :INNER_A].reshape(b, l, H_A, DK_A))
    k = _l2(qkv[..., INNER_A:2 * INNER_A].reshape(b, l, H_A, DK_A))
    v = qkv[..., 2 * INNER_A:].astype(F32).reshape(b, l, H_A, DV_A)
    g = -jnp.exp(a_log.astype(F32)) * jax.nn.softplus(ab[:, :, :, 0] + dt_bias.astype(F32))
    beta = jax.nn.sigmoid(ab[:, :, :, 1])
    o_f, s_f = _chunk_gated_delta(q, k, v, g[:, :, 0], beta[:, :, 0], s0_f.astype(F32))
    rev = lambda t: jnp.flip(t, axis=1)
    o_b, s_b = _chunk_gated_delta(rev(q), rev(k), rev(v), rev(g[:, :, 1]), rev(beta[:, :, 1]),
                                  s0_b.astype(F32))
    o = o_f + rev(o_b)
    o = _rms(o, norm_g) * jax.nn.silu(z.astype(F32))
    y = o.reshape(b, l, INNER_A).astype(h.dtype) @ w_out
    return y, s_f, s_b


def _rope_1d(x, pos):
    nf = x.shape[-1] // 2
    inv = ROPE_BASE ** (-jnp.arange(nf, dtype=F32) / nf)
    ang = pos.astype(F32)[:, None] * inv
    cos = jnp.cos(ang)[None, :, None, None, :]
    sin = jnp.sin(ang)[None, :, None, None, :]
    xf = x.astype(F32)
    x1, x2 = xf[..., :nf], xf[..., nf:]
    return jnp.concatenate([x1 * cos - x2 * sin, x2 * cos + x1 * sin], axis=-1).astype(x.dtype)


def _axial_rope(x, row, col):
    half = x.shape[-1] // 2
    return jnp.concatenate([_rope_1d(x[..., :half], row), _rope_1d(x[..., half:], col)], axis=-1)


def _diff_qkv(h, w_qkv):
    b, l, _ = h.shape
    qkv = (h @ w_qkv).reshape(b, l, 3, H_B, 2, DH_B)
    return qkv[:, :, 0], qkv[:, :, 1], qkv[:, :, 2].reshape(b, l, H_B, 2 * DH_B)


def _diff_lambda(lam_p, lam_init):
    lp = lam_p.astype(F32)
    return jnp.exp(jnp.sum(lp[0] * lp[1])) - jnp.exp(jnp.sum(lp[2] * lp[3])) + lam_init


def _diff_attend(q, k, v, lam, lam_init, norm_g, w_out):
    b, lq = q.shape[:2]
    nb = lq // Q_BLOCK
    qb = jnp.moveaxis(q.reshape(b, nb, Q_BLOCK, H_B, 2, DH_B), 1, 0)
    scale = DH_B ** -0.5

    def blk(qi):
        s = jnp.einsum('bqhcd,bkhcd->bhcqk', qi, k).astype(F32) * scale
        p = jax.nn.softmax(s, axis=-1)
        a = (p[:, :, 0] - lam * p[:, :, 1]).astype(v.dtype)
        return jnp.einsum('bhqk,bkhe->bqhe', a, v)

    o = lax.map(blk, qb)
    o = jnp.moveaxis(o, 0, 1).reshape(b, lq, H_B, 2 * DH_B)
    o = _rms(o, norm_g) * (1.0 - lam_init)
    return o.reshape(b, lq, H_B * 2 * DH_B) @ w_out


def _pool_mixer(h, w_pool, scale):
    b, l, d = h.shape
    hf = h.astype(F32)
    cs = jnp.concatenate([jnp.zeros((b, 1, d), F32), jnp.cumsum(hf, axis=1)], axis=1)
    t = jnp.arange(l)
    parts = []
    for gi, win in enumerate(POOL_WINDOWS):
        sl = slice(gi * POOL_GW, (gi + 1) * POOL_GW)
        lo = jnp.clip(t - win // 2, 0, l)
        hi = jnp.clip(t + win // 2, 0, l)
        cnt = (hi - lo).astype(F32)[None, :, None]
        csg = cs[:, :, sl]
        parts.append((csg[:, hi] - csg[:, lo]) / cnt - hf[:, :, sl])
    dlt = jnp.stack(parts, axis=2)
    y = jnp.einsum('blgc,gce->blge', dlt, w_pool.astype(F32)).reshape(b, l, d) * scale.astype(F32)
    return y.astype(h.dtype)


def setup_inputs(seed: int = 0) -> dict:
    key = jax.random.key(seed)
    ks = iter(jax.random.split(key, 40))
    D = D_MODEL

    def nrm(shape, s=1.0):
        return jax.random.normal(next(ks), shape, F32) * s

    inp = {}
    inp['x_prompt'] = nrm((BATCH, SEQ, D))
    inp['x_sample'] = nrm((DEC_BATCH, DEC_SEQ, D))
    inp['state_a'] = nrm((DEC_BATCH, N_A, 2, H_A, DK_A, DV_A), 0.1)
    inp['cache_k'] = nrm((DEC_BATCH, N_B, PAST_LEN, H_B, 2 * DH_B))
    inp['cache_v'] = nrm((DEC_BATCH, N_B, PAST_LEN, H_B, 2 * DH_B))
    inp['c'] = nrm((DEC_BATCH, D))
    inp['c_ctx'] = nrm((D,))
    inp['w_mod'] = nrm((DEPTH, D, N_MOD * D), 0.5 * D ** -0.5)
    inp['b_mod'] = nrm((DEPTH, N_MOD * D), 0.01)
    inp['norm_g'] = 1.0 + nrm((DEPTH, 3, D), 0.02)
    inp['ffn_wg'] = nrm((DEPTH, 2, D, D_FF), D ** -0.5)
    inp['ffn_wu'] = nrm((DEPTH, 2, D, D_FF), D ** -0.5)
    inp['ffn_wd'] = nrm((DEPTH, 2, D_FF, D), D_FF ** -0.5)
    inp['a_w_in'] = nrm((N_A, D, 4 * INNER_A + 4 * H_A), D ** -0.5)
    inp['a_conv'] = nrm((N_A, CONV_K, 3 * INNER_A), CONV_K ** -0.5)
    a_val = jax.random.uniform(next(ks), (N_A, 2, H_A), F32, minval=1.0, maxval=16.0)
    inp['a_A_log'] = jnp.log(a_val)
    dt = jnp.exp(jax.random.uniform(next(ks), (N_A, 2, H_A), F32,
                                    minval=math.log(1e-3), maxval=math.log(1e-1)))
    inp['a_dt_bias'] = dt + jnp.log(-jnp.expm1(-dt))
    inp['a_norm_g'] = 1.0 + nrm((N_A, DV_A), 0.02)
    inp['a_w_out'] = nrm((N_A, INNER_A, D), INNER_A ** -0.5)
    inp['b_w_qkv'] = nrm((N_B, D, 3 * H_B * 2 * DH_B), D ** -0.5)
    inp['b_lam'] = nrm((N_B, 4, DH_B), 0.1)
    inp['b_norm_g'] = 1.0 + nrm((N_B, 2 * DH_B), 0.02)
    inp['b_w_out'] = nrm((N_B, H_B * 2 * DH_B, D), (H_B * 2 * DH_B) ** -0.5)
    inp['c_w_pool'] = nrm((N_C, 4, POOL_GW, POOL_GW), POOL_GW ** -0.5)
    inp['c_scale'] = 1.0 + nrm((N_C, D), 0.02)
    inp['final_g'] = 1.0 + nrm((D,), 0.02)
    return inp


def reference(x_prompt, x_sample, state_a, cache_k, cache_v, c, c_ctx, w_mod, b_mod, norm_g,
              ffn_wg, ffn_wu, ffn_wd, a_w_in, a_conv, a_A_log, a_dt_bias, a_norm_g, a_w_out,
              b_w_qkv, b_lam, b_norm_g, b_w_out, c_w_pool, c_scale, final_g):
    bp, lp, _ = x_prompt.shape
    bs, ls, _ = x_sample.shape
    rows = ls // GRID_W
    row_pos = jnp.repeat(jnp.arange(rows), GRID_W)
    col_pos = jnp.tile(jnp.arange(GRID_W), rows)
    xp, xs = x_prompt, x_sample
    new_sa, new_k, new_v = [], [], []
    for i in range(DEPTH):
        kind, slot = i % N_MIXERS, i // N_MIXERS
        mp = _modulation(c_ctx[None, :], w_mod[i], b_mod[i])
        ms = _modulation(c, w_mod[i], b_mod[i])
        xp = _half_ffn(xp, mp, 0, norm_g[i, 0], ffn_wg[i, 0], ffn_wu[i, 0], ffn_wd[i, 0])
        xs = _half_ffn(xs, ms, 0, norm_g[i, 0], ffn_wg[i, 0], ffn_wu[i, 0], ffn_wd[i, 0])
        hp = _adanorm(xp, norm_g[i, 1], mp[:, :, 3], mp[:, :, 4])
        hs = _adanorm(xs, norm_g[i, 1], ms[:, :, 3], ms[:, :, 4])
        if kind == 0:
            wa = (a_w_in[slot], a_conv[slot], a_A_log[slot], a_dt_bias[slot], a_norm_g[slot], a_w_out[slot])
            z0 = jnp.zeros((bp, H_A, DK_A, DV_A), F32)
            yp, s_f, s_b = _gated_deltanet(hp, *wa, z0, z0)
            ys, _, _ = _gated_deltanet(hs, *wa, state_a[:, slot, 0], state_a[:, slot, 1])
            new_sa.append(jnp.stack([s_f, s_b], axis=1))
        elif kind == 1:
            lam_init = 0.8 - 0.6 * math.exp(-0.3 * i)
            lam = _diff_lambda(b_lam[slot], lam_init)
            qp, kp, vp = _diff_qkv(hp, b_w_qkv[slot])
            yp = _diff_attend(qp, kp, vp, lam, lam_init, b_norm_g[slot], b_w_out[slot])
            qs, ks_, vs = _diff_qkv(hs, b_w_qkv[slot])
            qs = _axial_rope(qs, row_pos, col_pos)
            ks_ = _axial_rope(ks_, row_pos, col_pos)
            ck = cache_k[:, slot].reshape(bs, cache_k.shape[2], H_B, 2, DH_B).astype(ks_.dtype)
            k_all = jnp.concatenate([ks_, ck], axis=1)
            v_all = jnp.concatenate([vs, cache_v[:, slot].astype(vs.dtype)], axis=1)
            ys = _diff_attend(qs, k_all, v_all, lam, lam_init, b_norm_g[slot], b_w_out[slot])
            new_k.append(kp.reshape(bp, lp, H_B, 2 * DH_B))
            new_v.append(vp)
        else:
            yp = _pool_mixer(hp, c_w_pool[slot], c_scale[slot])
            ys = _pool_mixer(hs, c_w_pool[slot], c_scale[slot])
        xp = xp + mp[:, :, 5] * yp
        xs = xs + ms[:, :, 5] * ys
        xp = _half_ffn(xp, mp, 6, norm_g[i, 2], ffn_wg[i, 1], ffn_wu[i, 1], ffn_wd[i, 1])
        xs = _half_ffn(xs, ms, 6, norm_g[i, 2], ffn_wg[i, 1], ffn_wu[i, 1], ffn_wd[i, 1])
    y_prompt = _rms(xp, final_g)
    y_sample = _rms(xs, final_g)
    state_a_new = jnp.stack(new_sa, axis=1)
    cache_k_new = jnp.stack(new_k, axis=1)
    cache_v_new = jnp.stack(new_v, axis=1)
    return (y_prompt, y_sample, state_a_new, cache_k_new, cache_v_new)
```

```cpp
#include <hip/hip_runtime.h>
#include <hip/hip_cooperative_groups.h>
#include <cstdio>
#include <cstring>
namespace cg = cooperative_groups;

#define LAS __attribute__((address_space(3)))
#define GAS __attribute__((address_space(1)))
#define LDG(T, ptr) (*(const GAS T*)(ptr))
#define STG(T, ptr) (*(GAS T*)(ptr))
#define DI __device__ __forceinline__
typedef unsigned short bf16_t;
typedef short bf16x8 __attribute__((ext_vector_type(8)));
typedef short s16x4 __attribute__((ext_vector_type(4)));
typedef float f32x2 __attribute__((ext_vector_type(2)));
typedef float f32x4 __attribute__((ext_vector_type(4)));
typedef float f32x16 __attribute__((ext_vector_type(16)));
typedef unsigned u32x2 __attribute__((ext_vector_type(2)));
typedef unsigned u32x4 __attribute__((ext_vector_type(4)));

constexpr size_t SZ_WGU1 = 5632ull * 1024 * 2;
constexpr size_t SZ_WD1 = 1024ull * 2816 * 2;
constexpr size_t SZ_WIN1 = 4128ull * 1024 * 2;
constexpr size_t OFF_WGU = 0;
constexpr size_t OFF_WD = OFF_WGU + 8 * SZ_WGU1;
constexpr size_t OFF_WIN = OFF_WD + 8 * SZ_WD1;
constexpr size_t OFF_WAO = OFF_WIN + 2 * SZ_WIN1;
constexpr size_t OFF_WQKV = OFF_WAO + 2 * 2097152ull;
constexpr size_t OFF_WBO = OFF_WQKV + 3072ull * 1024 * 2;
constexpr size_t OFF_WPOOL = OFF_WBO + 2097152ull;
constexpr size_t OFF_MODS = OFF_WPOOL + 1024ull * 256 * 2;
constexpr size_t OFF_X = OFF_MODS + 110592ull * 4;
constexpr size_t OFF_H = OFF_X + 8192ull * 1024 * 4;
constexpr size_t OFF_R1 = OFF_H + 8192ull * 1024 * 2;
constexpr size_t SZ_R1 = 134217728ull;
constexpr size_t OFF_HF = OFF_R1 + 67108864ull;
constexpr size_t OFF_R2 = OFF_R1 + SZ_R1;
constexpr size_t SZ_R2 = 2048ull * 73728;
constexpr size_t OFF_ZS = OFF_R2 + SZ_R2;
constexpr size_t OFF_GB = OFF_ZS + 8192ull * 1024 * 2;
constexpr size_t OFF_GL = OFF_GB + 8192ull * 32 * 4;
constexpr size_t OFF_BAR = OFF_GL + 8192;
constexpr size_t WS_END = OFF_BAR + 16384;
constexpr size_t CL_STRIDE = 73728, CL_WN = 0, CL_QG = 16384, CL_KD = 32768, CL_AT = 49152, CL_U = 57344;
constexpr size_t A_QB = 0;
constexpr size_t A_KS = A_QB + 8192ull * 1024 * 2;
constexpr size_t A_KP = A_KS + 2ull * 8 * 2304 * 128 * 2;
constexpr size_t A_VTS = A_KP + 16ull * 8 * 256 * 128 * 2;
constexpr size_t A_VTP = A_VTS + 2ull * 8 * 128 * 2304 * 2;
constexpr int LDS_BYTES = 147456;
constexpr unsigned DUP_MASK = 0x00000u;
constexpr float EPSF = 1e-6f;

struct Params {
    const float *x_prompt, *x_sample, *state_a, *cache_k, *cache_v, *c, *c_ctx, *w_mod, *b_mod, *norm_g, *ffn_wg, *ffn_wu, *ffn_wd, *a_w_in, *a_conv, *a_A_log, *a_dt_bias,
        *a_norm_g, *a_w_out, *b_w_qkv, *b_lam, *b_norm_g, *b_w_out, *c_w_pool, *c_scale, *final_g;
    float* out;
    unsigned char* ws;
    int ph_begin, ph_end;
};

DI int opq_tid() { const int w = __builtin_amdgcn_readfirstlane((int)threadIdx.x >> 6); const int l = __builtin_amdgcn_mbcnt_hi(~0u, __builtin_amdgcn_mbcnt_lo(~0u, 0u));
    int t = (w << 6) | l; asm volatile("" : "+v"(t)); return t; }
DI int opq_bid() { int t = blockIdx.x; asm volatile("" : "+s"(t)); return t; }
DI int opq_gdim() { int t = gridDim.x; asm volatile("" : "+s"(t)); return t; }
typedef __bf16 hwbf16x2 __attribute__((ext_vector_type(2)));
DI unsigned cvt_pk_bf16(float lo, float hi) { f32x2 v = {lo, hi}; hwbf16x2 b = __builtin_convertvector(v, hwbf16x2); return __builtin_bit_cast(unsigned, b); }
DI bf16_t to_bf16(float v) { return (bf16_t)(cvt_pk_bf16(v, v) & 0xffffu); }
DI float bf16_to_f(bf16_t b) { return __uint_as_float(((unsigned)b) << 16); }
DI int opq_lane() { int l = __builtin_amdgcn_mbcnt_hi(~0u, __builtin_amdgcn_mbcnt_lo(~0u, 0u)); asm volatile("" : "+v"(l)); return l; }
DI float shfl_lane(float v, int src) { return __int_as_float(__builtin_amdgcn_ds_bpermute(src << 2, __float_as_int(v))); }
DI float wave_sum(float v) {
    const int l = opq_lane();
#pragma unroll
    for (int o = 1; o < 64; o <<= 1) v += shfl_lane(v, l ^ o);
    return v;
}
DI float silu_f(float x) { return x * __builtin_amdgcn_rcpf(1.0f + __expf(-x)); }
DI float sigmoid_f(float x) { return 1.0f / (1.0f + expf(-x)); }
DI float softplus_f(float x) { return fmaxf(x, 0.f) + log1pf(expf(-fabsf(x))); }
#define LDSBAR() do { asm volatile("s_waitcnt lgkmcnt(0)" ::: "memory"); __builtin_amdgcn_s_barrier(); asm volatile("" ::: "memory"); } while (0)
DI int frag128(int row, int k) { return ((((row >> 5) * 8 + (k >> 4)) * 64 + ((k >> 3) & 1) * 32 + (row & 31)) << 3) + (k & 7); }
DI int frag64(int row, int k) { return ((((row >> 5) * 4 + (k >> 4)) * 64 + ((k >> 3) & 1) * 32 + (row & 31)) << 3) + (k & 7); }
template <int OFF> DI void gld16(u32x4& d, const void* p) { asm volatile("global_load_dwordx4 %0, %1, off offset:%2" : "=v"(d) : "v"(p), "n"(OFF) : "memory"); }
DI void gld4(float& d, const void* p) { asm volatile("global_load_dword %0, %1, off" : "=v"(d) : "v"(p) : "memory"); }
DI int crow(int reg, int h) { return (reg & 3) + 8 * (reg >> 2) + 4 * h; }
DI int row_cond(int r) { return r < 4096 ? 0 : 1 + ((r - 4096) >> 11); }

namespace pg8 {
constexpr int BM = 256, BK = 64, HALF = 128, HTB = HALF * BK * 2, STAGE_BYTES = 8 * HTB;
DI int lds_byte(int r, int c) { const int st = (r >> 4) * 2 + (c >> 5), rr = r & 15, cc = c & 31, ob = rr * 64 + cc * 2; return st * 1024 + (ob ^ (((ob >> 9) & 1) << 5)); }
DI void stage_rc(int b, int& R, int& C) { const int st = b / 1024, sb = b % 1024, swz = sb ^ (((sb >> 9) & 1) << 5); R = (st >> 1) * 16 + swz / 64; C = (st & 1) * 32 + (swz % 64) / 2; }
DI int perm32(int rho) { const int n = rho >> 4, i = rho & 15; return 8 * (i >> 2) + 4 * n + (i & 3); }
struct Unit { int pm, pn, ka, kb; };
struct Gemm { const bf16_t* A; const bf16_t* Bt; int lda, ldb, nt; };
struct Sched {
    int nM, nNv, nwg, G, c, nS, kper, apn;
    DI void init(int nM_, int nN_, int nS_, int kper_, int apn_, int G_, int c_) { nM = nM_; nNv = nN_ * nS_; nS = nS_; kper = kper_; apn = apn_; nwg = nM * nNv; G = G_; c = c_; }
    DI bool next(int i, Unit& u) const {
        const long L = (long)i * G + c; if (L >= nwg) return false;
        int wgid = (int)L; { const int q = nwg / 8, r = nwg % 8, xcd = wgid % 8, off = wgid / 8; wgid = (xcd < r ? xcd * (q + 1) : r * (q + 1) + (xcd - r) * q) + off; }
        const int nig = 8 * nNv, gid = wgid / nig, fm = gid * 8, gsz = (nM - fm) < 8 ? (nM - fm) : 8;
        u.pm = fm + ((wgid % nig) % gsz); const int pnv = (wgid % nig) / gsz;
        u.pn = pnv / nS; const int ks = pnv % nS; u.ka = ks * kper + u.pn * apn; u.kb = ks * kper; return true;
    }
};

struct EpiF32 {
    static constexpr bool PERM = false;
    float* C; int ldc;
    DI void operator()(const f32x4 (&acc)[2][2][4][2], const Unit& u, int wr, int wc, int fr, int fq) const {
        const int row0 = u.pm * BM + wr * 64 + fr, col0 = u.pn * BM + wc * 32 + 4 * fq;
#pragma unroll
        for (int ai = 0; ai < 2; ++ai)
#pragma unroll
            for (int m = 0; m < 4; ++m) { float* rowp = C + (size_t)(row0 + ai * HALF + m * 16) * ldc + col0;
#pragma unroll
                for (int bj = 0; bj < 2; ++bj)
#pragma unroll
                    for (int n = 0; n < 2; ++n) STG(f32x4, rowp + bj * HALF + n * 16) = acc[ai][bj][m][n]; }
    }
};
struct EpiSwiglu {
    static constexpr bool PERM = true;
    bf16_t* O;
    DI void operator()(const f32x4 (&acc)[2][2][4][2], const Unit& u, int wr, int wc, int fr, int fq) const {
        const int row0 = u.pm * BM + wr * 64 + fr, col0 = u.pn * 128 + wc * 32 + 8 * fq;
#pragma unroll
        for (int ai = 0; ai < 2; ++ai)
#pragma unroll
            for (int m = 0; m < 4; ++m) { bf16_t* rowp = O + (size_t)(row0 + ai * HALF + m * 16) * 2816 + col0;
                float v[8];
#pragma unroll
                for (int n = 0; n < 2; ++n)
#pragma unroll
                    for (int j = 0; j < 4; ++j) v[n * 4 + j] = silu_f(acc[ai][0][m][n][j]) * acc[ai][1][m][n][j];
                u32x4 w; w.x = cvt_pk_bf16(v[0], v[1]); w.y = cvt_pk_bf16(v[2], v[3]); w.z = cvt_pk_bf16(v[4], v[5]); w.w = cvt_pk_bf16(v[6], v[7]);
                STG(u32x4, rowp) = w; }
    }
};
struct EpiResid {
    static constexpr bool PERM = true;
    bf16_t* PB; const float* gate; const float* colscale; float cf;
    DI void operator()(const f32x4 (&acc)[2][2][4][2], const Unit& u, int wr, int wc, int fr, int fq) const {
        const int row0 = u.pm * BM + wr * 64 + fr, col0 = u.pn * BM + wc * 32 + 8 * fq;
        const int cond = u.pm < 16 ? 0 : (u.pm < 24 ? 1 : 2);
        bf16_t* P = PB + (u.kb ? (size_t)8388608 : (size_t)0);
        f32x4 gv[2][2];
#pragma unroll
        for (int bj = 0; bj < 2; ++bj)
#pragma unroll
            for (int n = 0; n < 2; ++n) { const int cc = col0 + bj * HALF + n * 4; f32x4 g = LDG(f32x4, gate + cond * 9216 + cc) * cf;
                if (colscale) g = g * LDG(f32x4, colscale + cc); gv[bj][n] = g; }
#pragma unroll
        for (int ai = 0; ai < 2; ++ai)
#pragma unroll
            for (int m = 0; m < 4; ++m) { bf16_t* rowp = P + (size_t)(row0 + ai * HALF + m * 16) * 1024 + col0;
#pragma unroll
                for (int bj = 0; bj < 2; ++bj) { const f32x4 v0 = acc[ai][bj][m][0] * gv[bj][0], v1 = acc[ai][bj][m][1] * gv[bj][1];
                    u32x4 w; w.x = cvt_pk_bf16(v0[0], v0[1]); w.y = cvt_pk_bf16(v0[2], v0[3]); w.z = cvt_pk_bf16(v1[0], v1[1]); w.w = cvt_pk_bf16(v1[2], v1[3]);
                    STG(u32x4, rowp + bj * HALF) = w; } }
    }
};

template <class Epi>
DI void gemm_phase(LAS unsigned char* lds, const Gemm g, const Sched& S, const Epi& E) {
    const int tid = opq_tid(), wid = __builtin_amdgcn_readfirstlane(tid >> 6), lane = tid & 63, wr = wid >> 2, wc = wid & 3, fr = lane & 15, fq = lane >> 4;
    const int nt = g.nt;
    unsigned voffA[2], voffB[2];
#pragma unroll
    for (int i = 0; i < 2; ++i) { int R, C; stage_rc(tid * 16 + i * 8192, R, C); const int Rb = Epi::PERM ? ((R & ~31) + perm32(R & 31)) : R;
        voffA[i] = (unsigned)(R * g.lda + C) * 2u; voffB[i] = (unsigned)(Rb * g.ldb + C) * 2u; }
    const size_t kstep = (size_t)(BK * 2);
    const size_t hstepA = (size_t)HALF * g.lda * 2, hstepB = (size_t)HALF * g.ldb * 2;
    const unsigned ldsw = (unsigned)wid * 1024u;
    const int aoff = lds_byte(wr * 64 + fr, fq * 8), boff = lds_byte(wc * 32 + fr, fq * 8);
#define PG8_SA(b, h) (((b) * 2 + (h)) * HTB)
#define PG8_SB(b, h) ((4 + (b) * 2 + (h)) * HTB)
#define PG8_STAGE(bufoff, gbase, voff) do { _Pragma("unroll") for (int _i = 0; _i < 2; ++_i) \
        __builtin_amdgcn_global_load_lds((const unsigned*)((const char*)(gbase) + (voff)[_i]), (LAS unsigned*)(lds + (bufoff) + ldsw + _i * 8192), 16, 0, 0); } while (0)
#define PG8_LDA(dst, b, h) do { _Pragma("unroll") for (int m = 0; m < 4; ++m) _Pragma("unroll") for (int k = 0; k < 2; ++k) dst[m][k] = *(const LAS bf16x8*)(lds + PG8_SA(b, h) + aoff + m * 2048 + k * 1024); } while (0)
#define PG8_LDB(dst, b, h) do { _Pragma("unroll") for (int n = 0; n < 2; ++n) _Pragma("unroll") for (int k = 0; k < 2; ++k) dst[n][k] = *(const LAS bf16x8*)(lds + PG8_SB(b, h) + boff + n * 2048 + k * 1024); } while (0)
#define PG8_MMA(ai, bj, At, Bt) do { __builtin_amdgcn_s_setprio(1); _Pragma("unroll") for (int m = 0; m < 4; ++m) _Pragma("unroll") for (int n = 0; n < 2; ++n) _Pragma("unroll") for (int k = 0; k < 2; ++k) \
        acc[ai][bj][m][n] = __builtin_amdgcn_mfma_f32_16x16x32_bf16(Bt[n][k], At[m][k], acc[ai][bj][m][n], 0, 0, 0); __builtin_amdgcn_s_setprio(0); } while (0)
#define PG8_WAIT_V(n) asm volatile("s_waitcnt vmcnt(" #n ")" ::: "memory")
#define PG8_WAIT_L(n) asm volatile("s_waitcnt lgkmcnt(" #n ")" ::: "memory")
#define PG8_BAR __builtin_amdgcn_s_barrier()
#define PG8_SCHED __builtin_amdgcn_sched_barrier(0)
    Unit cur, nxt; int ui = 0;
    if (!S.next(0, cur)) return;
    f32x4 acc[2][2][4][2];
#pragma unroll
    for (int a = 0; a < 2; ++a)
#pragma unroll
        for (int b = 0; b < 2; ++b)
#pragma unroll
            for (int m = 0; m < 4; ++m)
#pragma unroll
                for (int n = 0; n < 2; ++n) acc[a][b][m][n] = (f32x4){0.f, 0.f, 0.f, 0.f};
    bf16x8 At[4][2], B0[2][2], B1[2][2];
    const char* cA = (const char*)g.A + ((size_t)cur.pm * BM * g.lda + cur.ka) * 2; const char* cB = (const char*)g.Bt + ((size_t)cur.pn * BM * g.ldb + cur.kb) * 2;
    PG8_STAGE(PG8_SB(0, 0), cB, voffB); PG8_STAGE(PG8_SB(0, 1), cB + hstepB, voffB); PG8_STAGE(PG8_SA(0, 0), cA, voffA); PG8_STAGE(PG8_SA(0, 1), cA + hstepA, voffA);
    if (wr == 1) PG8_BAR;
    PG8_WAIT_V(2); PG8_BAR;
    PG8_STAGE(PG8_SB(1, 0), cB + kstep, voffB); PG8_STAGE(PG8_SA(1, 0), cA + kstep, voffA); PG8_STAGE(PG8_SB(1, 1), cB + hstepB + kstep, voffB);
    PG8_WAIT_V(6); PG8_BAR;
    for (;;) {
        const bool has_next = S.next(ui + 1, nxt);
        const char* nA = has_next ? (const char*)g.A + ((size_t)nxt.pm * BM * g.lda + nxt.ka) * 2 : cA; const char* nB = has_next ? (const char*)g.Bt + ((size_t)nxt.pn * BM * g.ldb + nxt.kb) * 2 : cB;
        for (int t = 0; t < nt; t += 2) {
            const bool last = (t == nt - 2);
            const char* a1 = cA + (size_t)(t + 1) * kstep;
            const char* a2 = last ? nA : cA + (size_t)(t + 2) * kstep; const char* b2 = last ? nB : cB + (size_t)(t + 2) * kstep;
            const char* a3 = a2 + kstep; const char* b3 = b2 + kstep;
            PG8_LDB(B0, 0, 0); PG8_LDB(B1, 0, 1); PG8_SCHED; PG8_LDA(At, 0, 0); PG8_STAGE(PG8_SA(1, 1), a1 + hstepA, voffA);
            PG8_WAIT_V(8); PG8_WAIT_L(0); PG8_BAR; PG8_MMA(0, 0, At, B0); PG8_MMA(0, 1, At, B1); PG8_BAR; PG8_SCHED;
            PG8_LDA(At, 0, 1); PG8_STAGE(PG8_SB(0, 0), b2, voffB); PG8_STAGE(PG8_SB(0, 1), b2 + hstepB, voffB); PG8_STAGE(PG8_SA(0, 0), a2, voffA);
            PG8_WAIT_V(8); PG8_WAIT_L(0); PG8_BAR; PG8_MMA(1, 0, At, B0); PG8_MMA(1, 1, At, B1); PG8_BAR; PG8_SCHED;
            PG8_LDB(B0, 1, 0); PG8_LDB(B1, 1, 1); PG8_SCHED; PG8_LDA(At, 1, 0); PG8_STAGE(PG8_SA(0, 1), a2 + hstepA, voffA);
            PG8_WAIT_V(8); PG8_WAIT_L(0); PG8_BAR; PG8_MMA(0, 0, At, B0); PG8_MMA(0, 1, At, B1); PG8_BAR; PG8_SCHED;
            PG8_LDA(At, 1, 1); PG8_STAGE(PG8_SB(1, 0), b3, voffB); PG8_STAGE(PG8_SB(1, 1), b3 + hstepB, voffB); PG8_STAGE(PG8_SA(1, 0), a3, voffA);
            PG8_WAIT_V(8); PG8_WAIT_L(0); PG8_BAR; PG8_MMA(1, 0, At, B0); PG8_MMA(1, 1, At, B1); PG8_BAR; PG8_SCHED;
        }
        if (wr == 0) PG8_BAR;
        E(acc, cur, wr, wc, fr, fq);
        if (!has_next) break;
#pragma unroll
        for (int a = 0; a < 2; ++a)
#pragma unroll
            for (int b = 0; b < 2; ++b)
#pragma unroll
                for (int m = 0; m < 4; ++m)
#pragma unroll
                    for (int n = 0; n < 2; ++n) acc[a][b][m][n] = (f32x4){0.f, 0.f, 0.f, 0.f};
        cur = nxt; cA = nA; cB = nB; ++ui;
        if (wr == 1) PG8_BAR;
    }
    PG8_WAIT_V(0);
    PG8_BAR;
#undef PG8_SA
#undef PG8_SB
#undef PG8_STAGE
#undef PG8_LDA
#undef PG8_LDB
#undef PG8_MMA
#undef PG8_WAIT_V
#undef PG8_WAIT_L
#undef PG8_BAR
#undef PG8_SCHED
}
}

template <class Epi>
DI void run_gemm(unsigned char* smem, const bf16_t* A, int lda, const bf16_t* Bt, int ldb, int nN, int nS, int kper, int apn, const Epi& E) {
    pg8::Gemm g; g.A = A; g.Bt = Bt; g.lda = lda; g.ldb = ldb; g.nt = kper / 64;
    pg8::Sched S; S.init(32, nN, nS, kper, apn, (int)opq_gdim(), (int)opq_bid());
    pg8::gemm_phase<Epi>((LAS unsigned char*)smem, g, S, E);
}

DI int rowmap(int n, int mode) { return mode == 0 ? n : ((n >> 7) * 256 + (n & 127) + (mode == 2 ? 128 : 0)); }
DI void tr_item(const float* W, int K, int N, bf16_t* WT, int mode, float* scr, int item, int lane) {
    const int nblk = N / 32, kb = item / nblk, nb = item % nblk, k0 = 64 * kb, n0 = 32 * nb;
    float wv[32];
#pragma unroll
    for (int i = 0; i < 32; ++i) wv[i] = LDG(float, W + (size_t)(k0 + 2 * i + (lane >> 5)) * N + n0 + (lane & 31));
#pragma unroll
    for (int i = 0; i < 32; ++i) scr[(2 * i + (lane >> 5)) * 33 + (lane & 31)] = wv[i];
    __builtin_amdgcn_fence(__ATOMIC_RELEASE, "wavefront"); __builtin_amdgcn_wave_barrier(); __builtin_amdgcn_fence(__ATOMIC_ACQUIRE, "wavefront");
    const int c = lane & 7;
#pragma unroll
    for (int j = 0; j < 4; ++j) { const int n = (lane >> 3) + 8 * j; const float* s = scr + (8 * c) * 33 + n;
        u32x4 o; o.x = cvt_pk_bf16(s[0 * 33], s[1 * 33]); o.y = cvt_pk_bf16(s[2 * 33], s[3 * 33]); o.z = cvt_pk_bf16(s[4 * 33], s[5 * 33]); o.w = cvt_pk_bf16(s[6 * 33], s[7 * 33]);
        STG(u32x4, WT + (size_t)rowmap(n0 + n, mode) * K + k0 + 8 * c) = o; }
    __builtin_amdgcn_fence(__ATOMIC_RELEASE, "wavefront"); __builtin_amdgcn_wave_barrier(); __builtin_amdgcn_fence(__ATOMIC_ACQUIRE, "wavefront");
}
DI void phase_convert_layer(const Params& p, unsigned char* smem, int L, int klo, int khi, int gw, int NGW) {
    const int lane = opq_tid() & 63, wave = opq_tid() >> 6;
    float* scr = (float*)smem + wave * (64 * 33);
    constexpr int I_F = 1408, I_L = 6 * I_F, I_IN = 16 * 129, I_SQ = 512, I_QKV = 1536, I_PL = 32;
    const int nL = I_L + (L == 1 ? I_QKV + I_SQ : (L == 2 ? 4 * I_PL : I_IN + I_SQ));
    if (khi > nL) khi = nL;
    for (int k = klo + gw; k < khi; k += NGW) {
        int r = k;
        if (r < I_L) { const int idx = 2 * L + r / (3 * I_F), q = r % (3 * I_F), which = q / I_F, item = q % I_F;
            if (which == 0) tr_item(p.ffn_wg + (size_t)idx * 1024 * 2816, 1024, 2816, (bf16_t*)(p.ws + OFF_WGU + idx * SZ_WGU1), 1, scr, item, lane);
            else if (which == 1) tr_item(p.ffn_wu + (size_t)idx * 1024 * 2816, 1024, 2816, (bf16_t*)(p.ws + OFF_WGU + idx * SZ_WGU1), 2, scr, item, lane);
            else tr_item(p.ffn_wd + (size_t)idx * 2816 * 1024, 2816, 1024, (bf16_t*)(p.ws + OFF_WD + idx * SZ_WD1), 0, scr, item, lane);
            continue; }
        r -= I_L;
        if (L == 1) { if (r < I_QKV) tr_item(p.b_w_qkv, 1024, 3072, (bf16_t*)(p.ws + OFF_WQKV), 0, scr, r, lane); else tr_item(p.b_w_out, 1024, 1024, (bf16_t*)(p.ws + OFF_WBO), 0, scr, r - I_QKV, lane); }
        else if (L == 2) { const int gI = r / I_PL; tr_item(p.c_w_pool + (size_t)gI * 65536, 256, 256, (bf16_t*)(p.ws + OFF_WPOOL) + (size_t)gI * 65536, 0, scr, r % I_PL, lane); }
        else { const int sl = L / 3;
            if (r < I_IN) tr_item(p.a_w_in + (size_t)sl * 1024 * 4128, 1024, 4128, (bf16_t*)(p.ws + OFF_WIN + sl * SZ_WIN1), 0, scr, r, lane);
            else tr_item(p.a_w_out + (size_t)sl * 1024 * 1024, 1024, 1024, (bf16_t*)(p.ws + OFF_WAO + sl * 2097152ull), 0, scr, r - I_IN, lane); }
    }
}
DI void phase_convert(const Params& p, unsigned char* smem) { phase_convert_layer(p, smem, 0, 0, 1 << 30, opq_bid() * 8 + (opq_tid() >> 6), opq_gdim() * 8); }
DI void convert_in_gemm_tail(const Params& p, unsigned char* smem, int layer, int part) {
    const int G = opq_gdim(), tail0 = 704 % G, bid = opq_bid();
    if (bid < tail0) return;
    const int gw = (bid - tail0) * 8 + (opq_tid() >> 6), NGW = (G - tail0) * 8;
    if (layer == 0 && part == 0) phase_convert_layer(p, smem, 1, 0, 3136, gw, NGW);
    else if (layer == 0) { phase_convert_layer(p, smem, 1, 3136, 4224, gw, NGW); phase_convert_layer(p, smem, 1, 8448, 10496, gw, NGW); }
    else if (layer == 1 && part == 0) phase_convert_layer(p, smem, 1, 4224, 8448, gw, NGW);
    else if (layer == 1) phase_convert_layer(p, smem, 3, 0, 3675, gw, NGW);
    else if (layer == 2 && part == 0) phase_convert_layer(p, smem, 3, 3675, 7350, gw, NGW);
    else if (layer == 2) phase_convert_layer(p, smem, 3, 7350, 11024, gw, NGW);
}
DI void convert_in_qkv_tail(const Params& p, unsigned char* smem) {
    const int G = opq_gdim(), tail0 = 384 % G, bid = opq_bid();
    if (G >= 384) { phase_convert_layer(p, smem, 2, 0, 1 << 30, bid * 8 + (opq_tid() >> 6), G * 8); return; }
    if (bid < tail0) return;
    phase_convert_layer(p, smem, 2, 0, 1 << 30, (bid - tail0) * 8 + (opq_tid() >> 6), (G - tail0) * 8);
}
DI void phase_modpart(const Params& p, unsigned char* smem) {
    float* sS = (float*)smem;
    float* sR = sS + 192;
    float* mpart = (float*)(p.ws + OFF_R1);
    const int t = opq_tid(), cgI = t & 255, kh = t >> 8;
    for (int task = opq_bid(); task < 576; task += opq_gdim()) {
        const int layer = task / 144, rem = task % 144, nc = rem / 16, kc = rem % 16;
        __syncthreads();
        if (t < 192) { const int cc = t / 64, kk = t % 64, k = kc * 64 + kk; const float v = cc == 0 ? p.c_ctx[k] : p.c[(cc - 1) * 1024 + k]; sS[t] = v / (1.0f + expf(-v)); }
        __syncthreads();
        f32x4 a0 = {0, 0, 0, 0}, a1 = a0, a2 = a0;
        const float* wp = p.w_mod + ((size_t)layer * 1024 + kc * 64 + kh * 32) * 9216 + nc * 1024 + cgI * 4;
#pragma unroll 8
        for (int i = 0; i < 32; ++i) { const f32x4 w = LDG(f32x4, wp + (size_t)i * 9216); const int kk = kh * 32 + i;
            a0 += w * sS[kk]; a1 += w * sS[64 + kk]; a2 += w * sS[128 + kk]; }
        if (kh == 1) { float* q = sR + cgI * 12; *(f32x4*)q = a0; *(f32x4*)(q + 4) = a1; *(f32x4*)(q + 8) = a2; }
        __syncthreads();
        if (kh == 0) { const float* q = sR + cgI * 12; a0 += *(const f32x4*)q; a1 += *(const f32x4*)(q + 4); a2 += *(const f32x4*)(q + 8);
            float* o = mpart + ((size_t)(kc * 4 + layer) * 3) * 9216 + nc * 1024 + cgI * 4;
            *(f32x4*)o = a0; *(f32x4*)(o + 9216) = a1; *(f32x4*)(o + 2 * 9216) = a2; }
    }
}
DI void phase_modreduce(const Params& p) {
    const float* mpart = (const float*)(p.ws + OFF_R1); float* mods = (float*)(p.ws + OFF_MODS);
    for (int i = opq_bid() * 512 + opq_tid(); i < 110592; i += opq_gdim() * 512) {
        const int layer = i / 27648, n = i % 9216; float s = p.b_mod[layer * 9216 + n];
#pragma unroll
        for (int kc = 0; kc < 16; ++kc) s += mpart[(size_t)kc * 110592 + i];
        mods[i] = s;
    }
}

DI void phase_norm(const Params& p, int mode, int nparts, const float* g, const float* modl, int jshift, int jscale) {
    const int lane = opq_tid() & 63, gw = opq_bid() * 8 + (opq_tid() >> 6), NGW = opq_gdim() * 8;
    float* X = (float*)(p.ws + OFF_X); bf16_t* H = (bf16_t*)(p.ws + OFF_H); float* HF = (float*)(p.ws + OFF_HF); const bf16_t* PB = (const bf16_t*)(p.ws + OFF_R1);
    for (int r = gw; r < 8192; r += NGW) {
        const float* src = mode == 1 ? (r < 4096 ? p.x_prompt + (size_t)r * 1024 : p.x_sample + (size_t)(r - 4096) * 1024) : X + (size_t)r * 1024;
        f32x4 v[4]; float ss = 0.f;
#pragma unroll
        for (int j = 0; j < 4; ++j) { const int cc = lane * 4 + 256 * j; v[j] = *(const f32x4*)(src + cc);
            if (nparts > 0) { const u32x2 q = *(const u32x2*)(PB + (size_t)r * 1024 + cc); v[j] += (f32x4){__uint_as_float(q.x << 16), __uint_as_float(q.x & 0xffff0000u), __uint_as_float(q.y << 16), __uint_as_float(q.y & 0xffff0000u)}; }
            if (nparts > 1) { const u32x2 q = *(const u32x2*)(PB + 8388608 + (size_t)r * 1024 + cc); v[j] += (f32x4){__uint_as_float(q.x << 16), __uint_as_float(q.x & 0xffff0000u), __uint_as_float(q.y << 16), __uint_as_float(q.y & 0xffff0000u)}; }
            ss += v[j].x * v[j].x + v[j].y * v[j].y + v[j].z * v[j].z + v[j].w * v[j].w; }
        const float rstd = rsqrtf(wave_sum(ss) * (1.0f / 1024.f) + EPSF);
        const int cond = row_cond(r);
#pragma unroll
        for (int j = 0; j < 4; ++j) { const int cc = lane * 4 + 256 * j; const f32x4 gg = *(const f32x4*)(g + cc);
            f32x4 y = v[j] * rstd * gg;
            if (mode != 3) { const f32x4 sc = *(const f32x4*)(modl + cond * 9216 + jscale * 1024 + cc), sh = *(const f32x4*)(modl + cond * 9216 + jshift * 1024 + cc);
                y = y * (sc + 1.0f) + sh;
                u32x2 w; w.x = cvt_pk_bf16(y.x, y.y); w.y = cvt_pk_bf16(y.z, y.w); *(u32x2*)(H + (size_t)r * 1024 + cc) = w;
                if (mode == 1 || nparts > 0) *(f32x4*)(X + (size_t)r * 1024 + cc) = v[j];
                if (mode == 2) *(f32x4*)(HF + (size_t)r * 1024 + cc) = y;
            } else *(f32x4*)(p.out + (size_t)r * 1024 + cc) = y; }
    }
}

DI void seq_of_row(int r, int& row0, int& pos, int& L) { if (r < 4096) { row0 = r & ~255; pos = r & 255; L = 256; } else { const int q = r - 4096; row0 = 4096 + (q & ~2047); pos = q & 2047; L = 2048; } }
DI void phase_dn_gates(const Params& p, int slot) {
    const int lane = opq_tid() & 63, gw = opq_bid() * 8 + (opq_tid() >> 6), NGW = opq_gdim() * 8;
    float* GB = (float*)(p.ws + OFF_GB);
    const bf16_t* H = (const bf16_t*)(p.ws + OFF_H); const bf16_t* WAB = (const bf16_t*)(p.ws + OFF_WIN + slot * SZ_WIN1) + (size_t)4096 * 1024;
    for (int task = gw; task < 512; task += NGW) {
        const int r0 = task * 16; f32x4 c0 = {0, 0, 0, 0}, c1 = c0;
        const bf16_t* ap = H + (size_t)(r0 + (lane & 15)) * 1024 + (lane >> 4) * 8; const bf16_t* bp = WAB + (size_t)(lane & 15) * 1024 + (lane >> 4) * 8;
#pragma unroll 8
        for (int ks = 0; ks < 32; ++ks) { const bf16x8 a = *(const bf16x8*)(ap + ks * 32), b0 = *(const bf16x8*)(bp + ks * 32), b1 = *(const bf16x8*)(bp + 16 * 1024 + ks * 32);
            c0 = __builtin_amdgcn_mfma_f32_16x16x32_bf16(a, b0, c0, 0, 0, 0); c1 = __builtin_amdgcn_mfma_f32_16x16x32_bf16(a, b1, c1, 0, 0, 0); }
        const int col = lane & 15, which = col >> 3, head = col & 7;
#pragma unroll
        for (int dir = 0; dir < 2; ++dir) { const float al = expf(p.a_A_log[slot * 16 + dir * 8 + head]), db = p.a_dt_bias[slot * 16 + dir * 8 + head];
#pragma unroll
            for (int j = 0; j < 4; ++j) { const float v = dir ? c1[j] : c0[j]; const float o = which == 0 ? -al * softplus_f(v + db) : sigmoid_f(v);
                GB[(size_t)(r0 + (lane >> 4) * 4 + j) * 32 + dir * 16 + col] = o; } }
    }
}
DI void cl_decode(int cp, int& row0, int& L, int& chunk, int& cpb, int& nch) { if (cp < 64) { row0 = (cp >> 2) * 256; L = 256; chunk = cp & 3; cpb = cp & ~3; nch = 4; } else { const int cs = cp - 64; row0 = 4096 + (cs >> 5) * 2048; L = 2048; chunk = cs & 31; cpb = 64 + (cs & ~31); nch = 32; } }
DI void phase_dn_chunk(const Params& p, unsigned char* smem, int slot) {
    float* Ks = (float*)smem; float* Qs = Ks + 64 * 129; float* Vs = Qs + 64 * 129; float* Lm0 = Vs + 64 * 129; float* Lm1 = Lm0 + 64 * 68; float* gcs = Lm1 + 64 * 68; float* bes = gcs + 128; float* egs = bes + 128;
    const float* PROJ = (const float*)(p.ws + OFF_R1); const float* GB = (const float*)(p.ws + OFF_GB); bf16_t* ZS = (bf16_t*)(p.ws + OFF_ZS);
    float* GL = (float*)(p.ws + OFF_GL); const float* cw = p.a_conv + (size_t)slot * 5 * 3072;
    for (int task = opq_bid(); task < 1024; task += opq_gdim()) {
        const int t = opq_tid(), lane = t & 63, wave = t >> 6, h = lane >> 5;
        const int head = task & 7, cp = task >> 3; int row0, L, chunk, cpb, nch; cl_decode(cp, row0, L, chunk, cpb, nch);
        unsigned char* rec0 = p.ws + OFF_R2 + (size_t)(((cpb + chunk) * 8 + head) * 2 + 0) * CL_STRIDE;
        unsigned char* rec1 = p.ws + OFF_R2 + (size_t)(((cpb + nch - 1 - chunk) * 8 + head) * 2 + 1) * CL_STRIDE;
        __syncthreads();
        {
            const int c = t & 127, i0 = (t >> 7) * 16, pos0 = 64 * chunk + i0;
#pragma unroll
            for (int tz = 0; tz < 3; ++tz) { const int cb = tz * 1024 + head * 128 + c; float x[20], w[5];
#pragma unroll
                for (int j = 0; j < 5; ++j) w[j] = LDG(float, cw + j * 3072 + cb);
#pragma unroll
                for (int m = 0; m < 20; ++m) { const int pp = pos0 - 2 + m; x[m] = (pp >= 0 && pp < L) ? LDG(float, PROJ + (size_t)(row0 + pp) * 4096 + cb) : 0.f; }
                float* dst = (tz == 0 ? Qs : (tz == 1 ? Ks : Vs)) + i0 * 129 + c;
#pragma unroll
                for (int k = 0; k < 16; ++k) { const float v = x[k] * w[0] + x[k + 1] * w[1] + x[k + 2] * w[2] + x[k + 3] * w[3] + x[k + 4] * w[4]; dst[k * 129] = silu_f(v); } }
            { const float* zr = PROJ + (size_t)(row0 + pos0) * 4096 + 3072 + head * 128 + c; bf16_t* zd = ZS + (size_t)(row0 + pos0) * 1024 + head * 128 + c; float z[16];
#pragma unroll
              for (int k = 0; k < 16; ++k) z[k] = LDG(float, zr + (size_t)k * 4096);
#pragma unroll
              for (int k = 0; k < 16; ++k) STG(bf16_t, zd + (size_t)k * 1024) = to_bf16(silu_f(z[k])); }
            if (t < 128) { const int d = t >> 6, io = d ? 63 - lane : lane; const size_t gi = (size_t)(row0 + 64 * chunk + io) * 32 + d * 16 + head;
                float s2 = LDG(float, GB + gi); bes[t] = LDG(float, GB + gi + 8);
#pragma unroll
                for (int o = 1; o < 64; o <<= 1) { const float u = shfl_lane(s2, lane >= o ? lane - o : lane); if (lane >= o) s2 += u; }
                gcs[t] = s2; egs[t] = __expf(s2);
                if (lane == 63) STG(float, GL + ((cpb + (d ? nch - 1 - chunk : chunk)) * 8 + head) * 2 + d) = __expf(s2); }
        }
        __syncthreads();
        {
            const int i = t >> 3, sg = (t & 7) * 16;
#pragma unroll
            for (int tz = 0; tz < 2; ++tz) { float* row = (tz == 0 ? Qs : Ks) + i * 129 + sg; float v[16]; float ss = 0.f;
#pragma unroll
                for (int k = 0; k < 16; ++k) { v[k] = row[k]; ss += v[k] * v[k]; }
                ss += shfl_lane(ss, lane ^ 1); ss += shfl_lane(ss, lane ^ 2); ss += shfl_lane(ss, lane ^ 4);
                float sc = rsqrtf(ss + EPSF); if (tz == 0) sc *= 0.08838834764831845f;
#pragma unroll
                for (int k = 0; k < 16; ++k) row[k] = v[k] * sc; }
        }
        __syncthreads();
        {
          const int pr = wave >> 2, ti = (wave >> 1) & 1, tj = wave & 1; const float* Xs = pr ? Qs : Ks;
          f32x16 acc; for (int i = 0; i < 16; ++i) acc[i] = 0.f;
          const float* ap = Xs + (32 * ti + (lane & 31)) * 129 + h; const float* bp = Ks + (32 * tj + (lane & 31)) * 129 + h;
#pragma unroll 8
          for (int s2 = 0; s2 < 64; ++s2) acc = __builtin_amdgcn_mfma_f32_32x32x2f32(ap[2 * s2], bp[2 * s2], acc, 0, 0, 0);
          const int j = 32 * tj + (lane & 31), jr = 63 - j; const float g0j = gcs[j], g1j = gcs[64 + jr];
          bf16_t* AT0 = (bf16_t*)(rec0 + CL_AT); bf16_t* AT1 = (bf16_t*)(rec1 + CL_AT);
#pragma unroll
          for (int r = 0; r < 16; ++r) { const int i = 32 * ti + crow(r, h), ir = 63 - i;
              const float d0 = __expf(fminf(gcs[i] - g0j, 0.f)), d1 = __expf(fminf(gcs[64 + ir] - g1j, 0.f));
              if (pr == 0) { if (i > j) Lm0[j * 68 + i] = bes[i] * acc[r] * d0; else if (i < j) Lm1[jr * 68 + ir] = bes[64 + ir] * acc[r] * d1; }
              else { STG(bf16_t, AT0 + frag64(i, j)) = to_bf16(i >= j ? acc[r] * d0 : 0.f); STG(bf16_t, AT1 + frag64(ir, jr)) = to_bf16(i <= j ? acc[r] * d1 : 0.f); } }
#pragma unroll 1
          for (int d = 0; d < 2; ++d) { unsigned* QG = (unsigned*)((d ? rec1 : rec0) + CL_QG); unsigned* KD = (unsigned*)((d ? rec1 : rec0) + CL_KD); const float gl = gcs[d * 64 + 63];
              for (int e = t; e < 4096; e += 512) { const int il = e >> 6, d2 = (e & 63) * 2, io = d ? 63 - il : il; const float f = egs[d * 64 + il]; STG(unsigned, QG + (frag128(il, d2) >> 1)) = cvt_pk_bf16(Qs[io * 129 + d2] * f, Qs[io * 129 + d2 + 1] * f); }
              for (int e = t; e < 4096; e += 512) { const int dd = e >> 5, i2 = (e & 31) * 2, ia = d ? 63 - i2 : i2, ib = d ? 62 - i2 : i2 + 1;
                  STG(unsigned, KD + (frag64(dd, i2) >> 1)) = cvt_pk_bf16(Ks[ia * 129 + dd] * __expf(gl - gcs[d * 64 + i2]), Ks[ib * 129 + dd] * __expf(gl - gcs[d * 64 + i2 + 1])); } } }
        __syncthreads();
        {
            const int d = t >> 8, c = t & 255; int zoff; asm volatile("v_mov_b32 %0, 0" : "=v"(zoff));
            const float* LmT = (d ? Lm1 : Lm0) + zoff; const float* be = bes + d * 64 + zoff; const float* eg = egs + d * 64 + zoff;
            const float* src = c < 128 ? Vs + c : Ks + (c - 128); const int rs = d ? -129 : 129; src += d ? 63 * 129 : 0;
            f32x2 xv[32];
#pragma unroll
            for (int i = 0; i < 64; ++i) { const float v = src[i * rs] * be[i] * (c < 128 ? 1.0f : eg[i]); if (i & 1) xv[i >> 1].y = v; else xv[i >> 1].x = v; }
#pragma unroll
            for (int j = 0; j < 63; ++j) { const float xj = (j & 1) ? xv[j >> 1].y : xv[j >> 1].x; const int lj = __float_as_int(LmT[j * 68 + lane]);
#pragma unroll
                for (int i2 = (j + 1) / 2; i2 < 32; ++i2) {
                    if (2 * i2 > j) { f32x2 l; l.x = __int_as_float(__builtin_amdgcn_readlane(lj, 2 * i2)); l.y = __int_as_float(__builtin_amdgcn_readlane(lj, 2 * i2 + 1)); xv[i2] -= l * xj; }
                    else xv[i2].y -= __int_as_float(__builtin_amdgcn_readlane(lj, 2 * i2 + 1)) * xj; } }
            unsigned char* rec = d ? rec1 : rec0;
            if (c < 128) {
#pragma unroll
                for (int rt2 = 0; rt2 < 2; ++rt2)
#pragma unroll
                    for (int h2 = 0; h2 < 2; ++h2) { u32x4* dq = (u32x4*)(rec + CL_U) + (((c >> 5) * 2 + rt2) * 2) * 64 + h2 * 32 + (c & 31);
#pragma unroll
                        for (int half = 0; half < 2; ++half) { u32x4 w;
#pragma unroll
                            for (int dd = 0; dd < 4; ++dd) { const int g = 2 * half + (dd >> 1), ii = 32 * rt2 + 8 * g + 4 * h2 + 2 * (dd & 1); w[dd] = cvt_pk_bf16(xv[ii >> 1].x, xv[ii >> 1].y); }
                            STG(u32x4, dq + half * 64) = w; } } }
            else { bf16_t* dst = (bf16_t*)(rec + CL_WN); const int dk = c - 128;
#pragma unroll
                for (int i = 0; i < 32; ++i) { STG(bf16_t, dst + frag128(2 * i, dk)) = to_bf16(-xv[i].x); STG(bf16_t, dst + frag128(2 * i + 1, dk)) = to_bf16(-xv[i].y); } }
        }
    }
}
struct ScanTask { int b, head, dir, slice, cp0, nch, row0, L, samp; };
DI ScanTask scan_decode(int task) { ScanTask q;
    if (task < 128) { const int sc = task >> 2; q.slice = task & 3; q.b = sc >> 4; q.head = (sc >> 1) & 7; q.dir = sc & 1; q.cp0 = 64 + q.b * 32; q.nch = 32; q.row0 = 4096 + q.b * 2048; q.L = 2048; q.samp = 1; }
    else { const int pid = task - 128, pc = pid >> 2; q.slice = pid & 3; q.b = pc >> 4; q.head = (pc >> 1) & 7; q.dir = pc & 1; q.cp0 = q.b * 4; q.nch = 4; q.row0 = q.b * 256; q.L = 256; q.samp = 0; }
    return q; }
DI int scan_task_of(int G, int bid, int k) { return G == 256 ? (bid < 128 ? (k == 0 ? bid : 128 + 896 + bid) : 128 + (bid - 128) + 128 * k) : bid + k * G; }
DI void phase_dn_scan(const Params& p, unsigned char* smem, int slot) {
    bf16_t* St = (bf16_t*)smem;
    bf16_t* Vn = St + 32 * 136;
    const float* GL = (const float*)(p.ws + OFF_GL);
    float* ODIR = (float*)(p.ws + OFF_R1);
    const int t = opq_tid(), lane = t & 63, wave = __builtin_amdgcn_readfirstlane(t >> 6), h = lane >> 5, l31 = lane & 31;
    const int G = opq_gdim(), bid = opq_bid();
    const int ntask = (G == 256) ? (bid < 128 ? 2 : 7) : ((1152 - bid + G - 1) / G);
    u32x4 R0[12], R1[12]; float gl0, gl1;
    for (int k = 0; k < ntask; ++k) {
        const ScanTask tk = scan_decode(scan_task_of(G, bid, k)); const bool has_next = k + 1 < ntask; const ScanTask tn = scan_decode(scan_task_of(G, bid, has_next ? k + 1 : k));
        const int b = tk.b, head = tk.head, dir = tk.dir, slice = tk.slice, cp0 = tk.cp0, nch = tk.nch, row0 = tk.row0, L = tk.L; const bool samp = tk.samp != 0;
        f32x16 sacc; for (int i = 0; i < 16; ++i) sacc[i] = 0.f;
        const int rt = wave & 1, dkt = wave & 3;
        const unsigned char* rbase = p.ws + OFF_R2 + (size_t)((cp0 * 8 + head) * 2 + dir) * CL_STRIDE;
        const unsigned char* nrbase = p.ws + OFF_R2 + (size_t)((tn.cp0 * 8 + tn.head) * 2 + tn.dir) * CL_STRIDE;
        const unsigned aoffs = (unsigned)(wave < 2 ? CL_WN : CL_QG) + (unsigned)(((wave < 4 ? rt : 0) * 8) * 64 + lane) * 16u;
        const unsigned boffs = wave < 2 ? (unsigned)CL_U + (unsigned)(((slice * 2 + rt) * 2) * 64 + lane) * 16u
                             : (wave < 4 ? (unsigned)CL_AT + (unsigned)((rt * 4) * 64 + lane) * 16u : (unsigned)CL_KD + (unsigned)((dkt * 4) * 64 + lane) * 16u);
        const unsigned nboffs = wave < 2 ? (unsigned)CL_U + (unsigned)(((tn.slice * 2 + rt) * 2) * 64 + lane) * 16u
                             : (wave < 4 ? (unsigned)CL_AT + (unsigned)((rt * 4) * 64 + lane) * 16u : (unsigned)CL_KD + (unsigned)((dkt * 4) * 64 + lane) * 16u);
#define SCAN_SRC(cidx, off, noff) ((cidx) < nch ? rbase + (size_t)(cidx) * 16 * CL_STRIDE + (off) : (has_next ? nrbase + (size_t)((cidx) - nch) * 16 * CL_STRIDE + (noff) : rbase + (size_t)(nch - 1) * 16 * CL_STRIDE + (off)))
#define SCAN_ISSUE_A(R, cidx) do { const unsigned char* a_ = SCAN_SRC(cidx, aoffs, aoffs); const unsigned char* a2_ = a_ + 4096; \
            gld16<0>(R[0], a_); gld16<1024>(R[1], a_); gld16<2048>(R[2], a_); gld16<3072>(R[3], a_); gld16<0>(R[4], a2_); gld16<1024>(R[5], a2_); gld16<2048>(R[6], a2_); gld16<3072>(R[7], a2_); } while (0)
#define SCAN_ISSUE_B(R, gl, cidx) do { const unsigned char* b_ = SCAN_SRC(cidx, boffs, nboffs); \
            const int gi_ = (cidx) < nch ? ((cp0 + (cidx)) * 8 + head) * 2 + dir : (has_next ? ((tn.cp0 + (cidx) - nch) * 8 + tn.head) * 2 + tn.dir : ((cp0 + nch - 1) * 8 + head) * 2 + dir); \
            gld16<0>(R[8], b_); gld16<1024>(R[9], b_); gld16<2048>(R[10], b_); gld16<3072>(R[11], b_); gld4(gl, GL + gi_); } while (0)
#define SCAN_WAIT(N, R, gl) asm volatile("s_waitcnt vmcnt(" #N ")" : "+v"(R[0]), "+v"(R[1]), "+v"(R[2]), "+v"(R[3]), "+v"(R[4]), "+v"(R[5]), "+v"(R[6]), "+v"(R[7]), "+v"(R[8]), "+v"(R[9]), "+v"(R[10]), "+v"(R[11]), "+v"(gl) :: "memory")
#define SCAN_STEP(c, R, gl) do { \
            SCAN_WAIT(13, R, gl); \
            f32x16 acc; \
            if (wave < 4) { \
                if (wave < 2) { _Pragma("unroll") for (int j = 0; j < 4; ++j) { acc[2 * j] = __uint_as_float(R[8][j] << 16); acc[2 * j + 1] = __uint_as_float(R[8][j] & 0xffff0000u); acc[8 + 2 * j] = __uint_as_float(R[9][j] << 16); acc[8 + 2 * j + 1] = __uint_as_float(R[9][j] & 0xffff0000u); } } \
                else { _Pragma("unroll") for (int r = 0; r < 16; ++r) acc[r] = 0.f; } \
                bf16x8 sb_[8]; _Pragma("unroll") for (int ks = 0; ks < 8; ++ks) sb_[ks] = *(const bf16x8*)(St + l31 * 136 + ks * 16 + 8 * h);     \
                _Pragma("unroll") for (int ks = 0; ks < 8; ++ks) acc = __builtin_amdgcn_mfma_f32_32x32x16_bf16(__builtin_bit_cast(bf16x8, R[ks]), sb_[ks], acc, 0, 0, 0); \
                if (wave < 2) { _Pragma("unroll") for (int gq = 0; gq < 4; ++gq) { u32x2 w; w.x = cvt_pk_bf16(acc[4 * gq], acc[4 * gq + 1]); w.y = cvt_pk_bf16(acc[4 * gq + 2], acc[4 * gq + 3]); \
                        *(u32x2*)(Vn + l31 * 72 + 32 * rt + 8 * gq + 4 * h) = w; } } \
            } \
            asm volatile("s_nop 7\n\ts_nop 7" ::: "memory"); \
            SCAN_ISSUE_A(R, (c) + 2); \
            LDSBAR(); \
            if (wave == 2 || wave == 3) { \
                bf16x8 vb_[4]; _Pragma("unroll") for (int ks = 0; ks < 4; ++ks) vb_[ks] = *(const bf16x8*)(Vn + l31 * 72 + ks * 16 + 8 * h); \
                _Pragma("unroll") for (int ks = 0; ks < 4; ++ks) acc = __builtin_amdgcn_mfma_f32_32x32x16_bf16(__builtin_bit_cast(bf16x8, R[8 + ks]), vb_[ks], acc, 0, 0, 0); \
                const unsigned voff = (unsigned)l31 + (unsigned)(dir ? 1 - h : h) * 4096u; \
                float* ob = ODIR + (size_t)dir * 8388608 + head * 128 + slice * 32 + (size_t)(row0 - (dir ? 4 : 0)) * 1024; \
                _Pragma("unroll") for (int r = 0; r < 16; ++r) { const int iu = 32 * rt + (r & 3) + 8 * (r >> 2); const int pu = dir ? L - 1 - (64 * (c) + iu) : 64 * (c) + iu; STG(float, ob + (size_t)pu * 1024 + voff) = acc[r]; } \
            } else if (wave >= 4) { \
                _Pragma("unroll") for (int r = 0; r < 16; ++r) sacc[r] *= gl; \
                bf16x8 vb_[4]; _Pragma("unroll") for (int ks = 0; ks < 4; ++ks) vb_[ks] = *(const bf16x8*)(Vn + l31 * 72 + ks * 16 + 8 * h); \
                _Pragma("unroll") for (int ks = 0; ks < 4; ++ks) sacc = __builtin_amdgcn_mfma_f32_32x32x16_bf16(__builtin_bit_cast(bf16x8, R[8 + ks]), vb_[ks], sacc, 0, 0, 0); \
                _Pragma("unroll") for (int gq = 0; gq < 4; ++gq) { u32x2 w; w.x = cvt_pk_bf16(sacc[4 * gq], sacc[4 * gq + 1]); w.y = cvt_pk_bf16(sacc[4 * gq + 2], sacc[4 * gq + 3]); \
                    *(u32x2*)(St + l31 * 136 + 32 * dkt + 8 * gq + 4 * h) = w; } \
            } \
            asm volatile("s_nop 7\n\ts_nop 7" ::: "memory"); \
            SCAN_ISSUE_B(R, gl, (c) + 2); \
            LDSBAR(); } while (0)
        __syncthreads();
        if (wave >= 4) {
            if (samp) { const float* s0 = p.state_a + ((((size_t)b * 2 + slot) * 2 + dir) * 8 + head) * 16384;
#pragma unroll
                for (int r = 0; r < 16; ++r) sacc[r] = LDG(float, s0 + (32 * dkt + crow(r, h)) * 128 + slice * 32 + l31); }
#pragma unroll
            for (int gq = 0; gq < 4; ++gq) { u32x2 w; w.x = cvt_pk_bf16(sacc[4 * gq], sacc[4 * gq + 1]); w.y = cvt_pk_bf16(sacc[4 * gq + 2], sacc[4 * gq + 3]);
                *(u32x2*)(St + l31 * 136 + 32 * dkt + 8 * gq + 4 * h) = w; } }
        __syncthreads();
        if (k == 0) { SCAN_ISSUE_A(R0, 0); SCAN_ISSUE_B(R0, gl0, 0); SCAN_ISSUE_A(R1, 1); SCAN_ISSUE_B(R1, gl1, 1); }
        for (int c = 0; c < nch; c += 2) { SCAN_STEP(c, R0, gl0); SCAN_STEP(c + 1, R1, gl1); }
        if (!samp && wave >= 4) { float* so = p.out + 8388608 + ((((size_t)b * 2 + slot) * 2 + dir) * 8 + head) * 16384;
#pragma unroll
            for (int r = 0; r < 16; ++r) STG(float, so + (32 * dkt + crow(r, h)) * 128 + slice * 32 + l31) = sacc[r]; }
        SCAN_WAIT(0, R0, gl0); SCAN_WAIT(0, R1, gl1);
#undef SCAN_SRC
#undef SCAN_ISSUE_A
#undef SCAN_ISSUE_B
#undef SCAN_WAIT
#undef SCAN_STEP
    }
}
DI void phase_dn_post(const Params& p, int slot) {
    const int lane = opq_tid() & 63, gw = opq_bid() * 8 + (opq_tid() >> 6), NGW = opq_gdim() * 8;
    const float* ODIR = (const float*)(p.ws + OFF_R1); const bf16_t* ZS = (const bf16_t*)(p.ws + OFF_ZS); bf16_t* H = (bf16_t*)(p.ws + OFF_H);
    const f32x2 g = *(const f32x2*)(p.a_norm_g + slot * 128 + lane * 2);
    for (int task = gw; task < 8192 * 8; task += NGW) {
        const size_t off = (size_t)(task >> 3) * 1024 + (task & 7) * 128 + lane * 2;
        const f32x2 a = *(const f32x2*)(ODIR + off), b = *(const f32x2*)(ODIR + 8388608 + off); const float o0 = a.x + b.x, o1 = a.y + b.y;
        const float rstd = rsqrtf(wave_sum(o0 * o0 + o1 * o1) * (1.0f / 128.f) + EPSF);
        const unsigned z = *(const unsigned*)(ZS + off);
        *(unsigned*)(H + off) = cvt_pk_bf16(o0 * rstd * g.x * __uint_as_float(z << 16), o1 * rstd * g.y * __uint_as_float(z & 0xffff0000u));
    }
}

DI void phase_at_prep(const Params& p, unsigned char* smem) {
    const int t = opq_tid(), lane = t & 63, gw = opq_bid() * 8 + (t >> 6), NGW = opq_gdim() * 8;
    const float* QKV = (const float*)(p.ws + OFF_R1); unsigned char* R2 = p.ws + OFF_R2;
    bf16_t* QB = (bf16_t*)(R2 + A_QB); bf16_t* KS = (bf16_t*)(R2 + A_KS); bf16_t* KP = (bf16_t*)(R2 + A_KP); bf16_t* VTS = (bf16_t*)(R2 + A_VTS); bf16_t* VTP = (bf16_t*)(R2 + A_VTP);
    float* ock = p.out + 16777216; float* ocv = p.out + 20971520;
    { const int st = lane >> 4, li = lane & 15, gq = li >> 2, cc = gq >> 1, half = gq & 1, f0 = 4 * (li & 3), d1 = cc * 64 + half * 32 + f0, d2 = d1 + 16;
      float invf[4];
#pragma unroll
      for (int k = 0; k < 4; ++k) invf[k] = exp2f(-(float)(f0 + k) * 0.8304820237218407f);
      for (int wt = gw; wt < 32768; wt += NGW) {
        const int T = wt * 4 + st, r = T >> 4, hq = T & 15, which = hq >> 3, head = hq & 7;
        const float* src = QKV + (size_t)r * 3072 + which * 1024 + head * 128;
        f32x4 x1 = LDG(f32x4, src + d1), x2 = LDG(f32x4, src + d2);
        bf16_t* dst;
        if (r >= 4096) { const int q = r - 4096, b = q >> 11, tk = q & 2047; const float pos = (float)(half ? (tk & 63) : (tk >> 6));
#pragma unroll
            for (int k = 0; k < 4; ++k) { const float ang = pos * invf[k]; const float n = rintf(ang * 0.15915494309189535f); float rr = fmaf(-n, 6.28125f, ang); rr = fmaf(-n, 1.9353071795864769e-3f, rr);
                const float sn = __sinf(rr), cs = __cosf(rr); const float o1 = x1[k] * cs - x2[k] * sn, o2 = x2[k] * cs + x1[k] * sn; x1[k] = o1; x2[k] = o2; }
            dst = which ? KS + ((size_t)(b * 8 + head) * 2304 + tk) * 128 : QB + (size_t)r * 1024 + head * 128;
        } else { const int b = r >> 8, tk = r & 255;
            dst = which ? KP + ((size_t)(b * 8 + head) * 256 + tk) * 128 : QB + (size_t)r * 1024 + head * 128;
            if (which) { float* o = ock + ((size_t)r * 8 + head) * 128; STG(f32x4, o + d1) = x1; STG(f32x4, o + d2) = x2; } }
        u32x2 w1, w2; w1.x = cvt_pk_bf16(x1[0], x1[1]); w1.y = cvt_pk_bf16(x1[2], x1[3]); w2.x = cvt_pk_bf16(x2[0], x2[1]); w2.y = cvt_pk_bf16(x2[2], x2[3]);
        STG(u32x2, dst + d1) = w1; STG(u32x2, dst + d2) = w2;
      } }
    for (int task = gw; task < 4096; task += NGW) { const int head = task & 7, pp = (task >> 3) & 255, b = task >> 11;
        const f32x2 v = *(const f32x2*)(p.cache_k + ((size_t)(b * 256 + pp) * 8 + head) * 128 + lane * 2);
        *(unsigned*)(KS + ((size_t)(b * 8 + head) * 2304 + 2048 + pp) * 128 + lane * 2) = cvt_pk_bf16(v.x, v.y); }
    float* Ts = (float*)smem;
    for (int task = opq_bid(); task < 1088; task += opq_gdim()) {
        __syncthreads();
        const int i = t >> 3, sg = (t & 7) * 16;
        int b, head, tile, nk; bf16_t* dstb; const float* srow; float* orow = nullptr;
        if (task < 576) { b = task / 288; const int rem = task % 288; head = rem / 36; tile = rem % 36; nk = 2304; dstb = VTS + (size_t)(b * 8 + head) * 128 * 2304;
            if (tile < 32) srow = QKV + (size_t)(4096 + b * 2048 + tile * 64 + i) * 3072 + 2048 + head * 128; else srow = p.cache_v + ((size_t)(b * 256 + (tile - 32) * 64 + i) * 8 + head) * 128; }
        else { const int q = task - 576; b = q >> 5; head = (q >> 2) & 7; tile = q & 3; nk = 256; dstb = VTP + (size_t)(b * 8 + head) * 128 * 256;
            srow = QKV + (size_t)(b * 256 + tile * 64 + i) * 3072 + 2048 + head * 128; orow = ocv + ((size_t)(b * 256 + tile * 64 + i) * 8 + head) * 128; }
#pragma unroll
        for (int q = 0; q < 4; ++q) { const f32x4 a = LDG(f32x4, srow + sg + q * 4); if (orow) STG(f32x4, orow + sg + q * 4) = a;
#pragma unroll
            for (int j = 0; j < 4; ++j) Ts[i * 129 + sg + q * 4 + j] = a[j]; }
        __syncthreads();
        { const int e = t >> 2, ck = (t & 3) * 16; u32x4 w0, w1; const float* s = Ts + ck * 129 + e;
          w0.x = cvt_pk_bf16(s[0], s[129]); w0.y = cvt_pk_bf16(s[2 * 129], s[3 * 129]); w0.z = cvt_pk_bf16(s[4 * 129], s[5 * 129]); w0.w = cvt_pk_bf16(s[6 * 129], s[7 * 129]);
          w1.x = cvt_pk_bf16(s[8 * 129], s[9 * 129]); w1.y = cvt_pk_bf16(s[10 * 129], s[11 * 129]); w1.z = cvt_pk_bf16(s[12 * 129], s[13 * 129]); w1.w = cvt_pk_bf16(s[14 * 129], s[15 * 129]);
          bf16_t* d = dstb + (size_t)e * nk + tile * 64 + ck; STG(u32x4, d) = w0; STG(u32x4, d + 8) = w1; }
    }
}
DI void phase_attn(const Params& p, unsigned char* smem, float lam_init) {
    const int t = opq_tid(), lane = t & 63, wave = __builtin_amdgcn_readfirstlane(t >> 6), h = lane >> 5, l31 = lane & 31, cc = wave >> 2, rq = wave & 3;
    unsigned char* R2 = p.ws + OFF_R2;
    const bf16_t* QB = (const bf16_t*)(R2 + A_QB); const bf16_t* KS = (const bf16_t*)(R2 + A_KS); const bf16_t* KP = (const bf16_t*)(R2 + A_KP);
    const bf16_t* VTS = (const bf16_t*)(R2 + A_VTS); const bf16_t* VTP = (const bf16_t*)(R2 + A_VTP); bf16_t* H = (bf16_t*)(p.ws + OFF_H);
    bf16_t* Kt = (bf16_t*)smem;
    bf16_t* Vt = Kt + 2 * 64 * 136;
    float* OX = (float*)smem;
    float d01 = 0.f, d23 = 0.f;
    for (int i = 0; i < 64; ++i) { d01 += p.b_lam[i] * p.b_lam[64 + i]; d23 += p.b_lam[128 + i] * p.b_lam[192 + i]; }
    const float lam = expf(d01) - expf(d23) + lam_init;
    const float sc2 = 0.125f * 1.4426950408889634f;
    for (int item = opq_bid(); item < 512; item += opq_gdim()) {
        int b, head, qrow0, nk; const bf16_t *Kb, *Vb;
        if (item < 256) { b = item >> 7; head = (item >> 4) & 7; qrow0 = 4096 + b * 2048 + (item & 15) * 128; nk = 2304; Kb = KS + (size_t)(b * 8 + head) * 2304 * 128; Vb = VTS + (size_t)(b * 8 + head) * 128 * 2304; }
        else { const int j = item - 256; b = j >> 4; head = (j >> 1) & 7; qrow0 = b * 256 + (j & 1) * 128; nk = 256; Kb = KP + (size_t)(b * 8 + head) * 256 * 128; Vb = VTP + (size_t)(b * 8 + head) * 128 * 256; }
        const int nkt = nk / 64, qrow = qrow0 + rq * 32 + l31;
        bf16x8 bq[4];
#pragma unroll
        for (int ks = 0; ks < 4; ++ks) bq[ks] = LDG(bf16x8, QB + (size_t)qrow * 1024 + head * 128 + cc * 64 + ks * 16 + 8 * h);
        f32x16 ao[4];
#pragma unroll
        for (int et = 0; et < 4; ++et) for (int i = 0; i < 16; ++i) ao[et][i] = 0.f;
        float mrun = -1e30f, lrun = 0.f;
        const int kkey = t >> 3, kch = t & 7;
        u32x4 kr[2], vr[2];
#pragma unroll
        for (int u = 0; u < 2; ++u) { const int id = t + u * 512, key = id >> 4, ch = id & 15; kr[u] = LDG(u32x4, Kb + (size_t)key * 128 + ch * 8);
            const int e = id >> 3, c8 = id & 7; vr[u] = LDG(u32x4, Vb + (size_t)e * nk + c8 * 8); }
        __syncthreads();
#pragma unroll
        for (int u = 0; u < 2; ++u) { const int id = t + u * 512, key = id >> 4, ch = id & 15; *(u32x4*)(Kt + key * 136 + ch * 8) = kr[u];
            const int e = id >> 3, c8 = id & 7; *(u32x4*)(Vt + e * 72 + c8 * 8) = vr[u]; }
        (void)kkey; (void)kch;
        for (int kt = 0; kt < nkt; ++kt) {
            LDSBAR();
            const int buf = kt & 1; const bool more = kt + 1 < nkt;
            if (more) {
#pragma unroll
                for (int u = 0; u < 2; ++u) { const int id = t + u * 512, key = id >> 4, ch = id & 15; kr[u] = LDG(u32x4, Kb + (size_t)((kt + 1) * 64 + key) * 128 + ch * 8);
                    const int e = id >> 3, c8 = id & 7; vr[u] = LDG(u32x4, Vb + (size_t)e * nk + (kt + 1) * 64 + c8 * 8); } }
            const bf16_t* Kc = Kt + buf * 64 * 136; const bf16_t* Vc = Vt + buf * 128 * 72;
            f32x16 as[2];
#pragma unroll
            for (int sub = 0; sub < 2; ++sub) { for (int i = 0; i < 16; ++i) as[sub][i] = 0.f;
#pragma unroll
                for (int ks = 0; ks < 4; ++ks) { const bf16x8 a = *(const bf16x8*)(Kc + (32 * sub + l31) * 136 + cc * 64 + ks * 16 + 8 * h);
                    as[sub] = __builtin_amdgcn_mfma_f32_32x32x16_bf16(a, bq[ks], as[sub], 0, 0, 0); } }
            float mx = -1e30f;
#pragma unroll
            for (int sub = 0; sub < 2; ++sub)
#pragma unroll
                for (int i = 0; i < 16; ++i) mx = fmaxf(mx, as[sub][i]);
            mx = fmaxf(mx, shfl_lane(mx, lane ^ 32)) * sc2;
            const float mnew = fmaxf(mrun, mx), alpha = __builtin_amdgcn_exp2f(mrun - mnew); mrun = mnew;
            float ls = 0.f;
#pragma unroll
            for (int sub = 0; sub < 2; ++sub)
#pragma unroll
                for (int i = 0; i < 16; ++i) { const float pv = __builtin_amdgcn_exp2f(as[sub][i] * sc2 - mnew); as[sub][i] = pv; ls += pv; }
            lrun = lrun * alpha + ls;
#pragma unroll
            for (int et = 0; et < 4; ++et)
#pragma unroll
                for (int i = 0; i < 16; ++i) ao[et][i] *= alpha;
            bf16x8 pf[2][2];
#pragma unroll
            for (int sub = 0; sub < 2; ++sub)
#pragma unroll
                for (int s = 0; s < 2; ++s) { u32x4 w; w.x = cvt_pk_bf16(as[sub][8 * s], as[sub][8 * s + 1]); w.y = cvt_pk_bf16(as[sub][8 * s + 2], as[sub][8 * s + 3]);
                    w.z = cvt_pk_bf16(as[sub][8 * s + 4], as[sub][8 * s + 5]); w.w = cvt_pk_bf16(as[sub][8 * s + 6], as[sub][8 * s + 7]); pf[sub][s] = __builtin_bit_cast(bf16x8, w); }
#pragma unroll
            for (int et = 0; et < 4; ++et)
#pragma unroll
                for (int sub = 0; sub < 2; ++sub)
#pragma unroll
                    for (int s = 0; s < 2; ++s) { const bf16_t* vp = Vc + (32 * et + l31) * 72 + 32 * sub + 16 * s + 4 * h;
                        const s16x4 lo = *(const s16x4*)vp, hi = *(const s16x4*)(vp + 8);
                        const bf16x8 a = __builtin_shufflevector(lo, hi, 0, 1, 2, 3, 4, 5, 6, 7);
                        ao[et] = __builtin_amdgcn_mfma_f32_32x32x16_bf16(a, pf[sub][s], ao[et], 0, 0, 0); }
            if (more) {
                bf16_t* Kn = Kt + (buf ^ 1) * 64 * 136; bf16_t* Vnx = Vt + (buf ^ 1) * 128 * 72;
#pragma unroll
                for (int u = 0; u < 2; ++u) { const int id = t + u * 512, key = id >> 4, ch = id & 15; *(u32x4*)(Kn + key * 136 + ch * 8) = kr[u];
                    const int e = id >> 3, c8 = id & 7; *(u32x4*)(Vnx + e * 72 + c8 * 8) = vr[u]; } }
        }
        const float ltot = lrun + shfl_lane(lrun, lane ^ 32); const float inv = 1.0f / ltot;
        __syncthreads();
        if (cc == 1) { const float f = -lam * inv;
#pragma unroll
            for (int et = 0; et < 4; ++et)
#pragma unroll
                for (int i = 0; i < 16; ++i) OX[((rq * 4 + et) * 16 + i) * 64 + lane] = ao[et][i] * f; }
        __syncthreads();
        if (cc == 0) { float ss = 0.f;
#pragma unroll
            for (int et = 0; et < 4; ++et)
#pragma unroll
                for (int i = 0; i < 16; ++i) { const float o = ao[et][i] * inv + OX[((rq * 4 + et) * 16 + i) * 64 + lane]; ao[et][i] = o; ss += o * o; }
            ss += shfl_lane(ss, lane ^ 32);
            const float rstd = rsqrtf(ss * (1.0f / 128.f) + EPSF) * (1.0f - lam_init);
            bf16_t* op = H + (size_t)qrow * 1024 + head * 128;
#pragma unroll
            for (int et = 0; et < 4; ++et)
#pragma unroll
                for (int gq = 0; gq < 4; ++gq) { const int e0 = 32 * et + 8 * gq + 4 * h; const f32x4 g = LDG(f32x4, p.b_norm_g + e0);
                    u32x2 w; w.x = cvt_pk_bf16(ao[et][4 * gq] * rstd * g.x, ao[et][4 * gq + 1] * rstd * g.y); w.y = cvt_pk_bf16(ao[et][4 * gq + 2] * rstd * g.z, ao[et][4 * gq + 3] * rstd * g.w);
                    STG(u32x2, op + e0) = w; } }
    }
}

DI void phase_pool(const Params& p) {
    const float* HF = (const float*)(p.ws + OFF_HF); bf16_t* H = (bf16_t*)(p.ws + OFF_H);
    for (int i = opq_bid() * 512 + opq_tid(); i < 8192 * 256; i += opq_gdim() * 512) {
        const int r = i >> 8, c4 = (i & 255) * 4, gI = c4 >> 8, hw = 1 << gI;
        int row0, pos, L; seq_of_row(r, row0, pos, L);
        const int lo = max(pos - hw, 0), hi = min(pos + hw, L);
        f32x4 s = {0, 0, 0, 0};
        for (int q = lo; q < hi; ++q) s += *(const f32x4*)(HF + (size_t)(row0 + q) * 1024 + c4);
        const f32x4 me = *(const f32x4*)(HF + (size_t)r * 1024 + c4);
        const float ic = 1.0f / (float)(hi - lo); s = s * ic - me;
        u32x2 w; w.x = cvt_pk_bf16(s.x, s.y); w.y = cvt_pk_bf16(s.z, s.w); *(u32x2*)(H + (size_t)r * 1024 + c4) = w;
    }
}


#define XB_TMO      128
#define XB_XCNT(j)  (256  + 64 * (j))
#define XB_XSUB(j)  (1280 + 64 * (j))
#define XB_XGEN(j)  (2304 + 64 * (j))
#define XB_TOP      3328
#define XB_TOPGEN   3392
#define XCD_BAR_WORDS 3456
#define XB_SPIN_CAP (1u << 20)
DI unsigned xb_ld(unsigned* p)              { return __hip_atomic_load(p, __ATOMIC_RELAXED, __HIP_MEMORY_SCOPE_AGENT); }
DI unsigned xb_add(unsigned* p, unsigned v) { return __hip_atomic_fetch_add(p, v, __ATOMIC_RELAXED, __HIP_MEMORY_SCOPE_AGENT); }
DI unsigned xb_xcc_id() { return (unsigned)__builtin_amdgcn_s_getreg((3 << 11) | 20) & 0xFu; }
#define XB_SPIN(cond, bar) do { unsigned _sp = 0; while (cond) { __builtin_amdgcn_s_sleep(1); \
    if ((++_sp & 255u) == 0u) { if (xb_ld(&(bar)[XB_TMO])) break; if (_sp > XB_SPIN_CAP) { atomicAdd(&(bar)[XB_TMO], 1u); break; } } } } while (0)
DI void xcd_barrier_complete(unsigned* bar, unsigned x, unsigned& nloc, unsigned& nx) {
    const unsigned G = gridDim.x;
    unsigned sum, cnt, mine, sp = 0u;
    for (;;) {
        sum = 0u; cnt = 0u; mine = 0u;
#pragma unroll
        for (unsigned j = 0; j < 16; ++j) { const unsigned c = xb_ld(&bar[XB_XCNT(j)]); sum += c; cnt += (c > 0u) ? 1u : 0u; mine = (j == x) ? c : mine; }
        if (sum == G) break;
        __builtin_amdgcn_s_sleep(1);
        if ((++sp & 255u) == 0u) { if (xb_ld(&bar[XB_TMO])) break; if (sp > XB_SPIN_CAP) { atomicAdd(&bar[XB_TMO], 1u); break; } }
    }
    nloc = mine > 0u ? mine : 1u; nx = cnt > 0u ? cnt : 1u;
}
DI void xcd_barrier(unsigned* bar, volatile LAS unsigned* st) {
    asm volatile("s_waitcnt vmcnt(0)" ::: "memory");
    __syncthreads();
    if (threadIdx.x == 0) {
        const unsigned x = xb_xcc_id();
        __builtin_amdgcn_s_waitcnt(0);
        unsigned nloc = st[0], nx = st[1];
        if (nloc == 0u) { xcd_barrier_complete(bar, x, nloc, nx); st[0] = nloc; st[1] = nx; }
        const unsigned old = xb_add(&bar[XB_XSUB(x)], 1u);
        const unsigned gen = old / nloc;
        if (old + 1u == (gen + 1u) * nloc) {
            __builtin_amdgcn_fence(__ATOMIC_RELEASE, "agent");
            asm volatile("s_waitcnt vmcnt(0)" ::: "memory");
            const unsigned og = xb_add(&bar[XB_TOP], 1u);
            const unsigned tg = og / nx;
            if (og + 1u == (tg + 1u) * nx) xb_add(&bar[XB_TOPGEN], 1u);
            else XB_SPIN(xb_ld(&bar[XB_TOPGEN]) == tg, bar);
            __builtin_amdgcn_fence(__ATOMIC_ACQUIRE, "agent");
            xb_add(&bar[XB_XGEN(x)], 1u);
            asm volatile("s_waitcnt vmcnt(0)" ::: "memory");
        } else {
            XB_SPIN(xb_ld(&bar[XB_XGEN(x)]) == gen, bar);
            __builtin_amdgcn_fence(__ATOMIC_ACQUIRE, "agent");
            asm volatile("s_waitcnt vmcnt(0)" ::: "memory");
        }
    }
    __syncthreads();
}

__shared__ Params s_params;
DI Params load_params() {
    Params q; const unsigned* src = (const unsigned*)&s_params; unsigned* dst = (unsigned*)&q;
#pragma unroll
    for (int i = 0; i < (int)(sizeof(Params) / 4); ++i) dst[i] = __builtin_amdgcn_readfirstlane(src[i]);
    return q;
}
__global__ void __launch_bounds__(512, 2) mega(Params pk) {
    extern __shared__ __attribute__((aligned(16))) unsigned char smem[];
    cg::grid_group grid = cg::this_grid();
    __shared__ uint4 xb_words;
    if (opq_tid() == 0) { s_params = pk; xb_words = make_uint4(0u, 0u, 0u, 0u); }
    if (blockIdx.x == 0) for (int i = threadIdx.x; i < XCD_BAR_WORDS; i += 512) ((unsigned*)(pk.ws + OFF_BAR))[i] = 0u;
    __syncthreads();
#define GSYNC() xcd_barrier((unsigned*)(load_params().ws + OFF_BAR), (volatile LAS unsigned*)&xb_words)
#define PHASE(ty, ...) do { { const Params p = load_params(); const float cfmul = 1.0f; (void)cfmul; __VA_ARGS__; } \
        if ((DUP_MASK >> (ty)) & 1) { GSYNC(); const Params p = load_params(); const float cfmul = 1.0f; (void)cfmul; __VA_ARGS__; } \
        if ((DUP_MASK >> 15) & 1) GSYNC(); \
        GSYNC(); } while (0)
#define WS_H ((bf16_t*)(p.ws + OFF_H))
#define WS_X ((float*)(p.ws + OFF_X))
#define WS_ACT ((bf16_t*)(p.ws + OFF_R2))
#define MODL ((const float*)(p.ws + OFF_MODS) + layer * 27648)
    { const Params p = load_params(); phase_convert(p, smem); phase_modpart(p, smem); if (DUP_MASK & 1) { phase_convert(p, smem); phase_modpart(p, smem); } }
    grid.sync();
    if (threadIdx.x == 0) (void)xb_add((unsigned*)(load_params().ws + OFF_BAR) + XB_XCNT(xb_xcc_id()), 1u);
    PHASE(1, phase_modreduce(p));
    for (int layer = 0; layer < 4; ++layer) {
        const int kind = layer % 3, slot = layer / 3;
        for (int sub = 0; sub < 3; ++sub) {
            const int j0 = sub * 3;
            const int nmode = (layer == 0 && sub == 0) ? 1 : ((sub == 1 && kind == 2) ? 2 : 0);
            const int nparts = (layer == 0 && sub == 0) ? 0 : ((sub == 2 && kind == 2) ? 1 : 2);
            PHASE(2, phase_norm(p, nmode, cfmul != 0.f ? nparts : 0, p.norm_g + (layer * 3 + sub) * 1024, MODL, j0, j0 + 1));
            if (sub != 1) {
                const int idx = layer * 2 + (sub >> 1);
                PHASE(3, { pg8::EpiSwiglu E; E.O = WS_ACT; run_gemm(smem, WS_H, 1024, (const bf16_t*)(p.ws + OFF_WGU + idx * SZ_WGU1), 1024, 22, 1, 1024, 0, E); convert_in_gemm_tail(p, smem, layer, sub >> 1); });
                PHASE(4, { pg8::EpiResid E; E.PB = (bf16_t*)(p.ws + OFF_R1); E.gate = MODL + (j0 + 2) * 1024; E.colscale = nullptr; E.cf = 0.5f * cfmul;
                        run_gemm(smem, WS_ACT, 2816, (const bf16_t*)(p.ws + OFF_WD + idx * SZ_WD1), 2816, 4, 2, 1408, 0, E); });
            } else if (kind == 0) {
                PHASE(5, { pg8::EpiF32 E; E.C = (float*)(p.ws + OFF_R1); E.ldc = 4096; run_gemm(smem, WS_H, 1024, (const bf16_t*)(p.ws + OFF_WIN + slot * SZ_WIN1), 1024, 16, 1, 1024, 0, E); phase_dn_gates(p, slot); });
                PHASE(7, phase_dn_chunk(p, smem, slot));
                PHASE(8, phase_dn_scan(p, smem, slot));
                PHASE(9, phase_dn_post(p, slot));
                PHASE(10, { pg8::EpiResid E; E.PB = (bf16_t*)(p.ws + OFF_R1); E.gate = MODL + 5 * 1024; E.colscale = nullptr; E.cf = cfmul;
                        run_gemm(smem, WS_H, 1024, (const bf16_t*)(p.ws + OFF_WAO + slot * 2097152ull), 1024, 4, 2, 512, 0, E); });
            } else if (kind == 1) {
                PHASE(11, { pg8::EpiF32 E; E.C = (float*)(p.ws + OFF_R1); E.ldc = 3072; run_gemm(smem, WS_H, 1024, (const bf16_t*)(p.ws + OFF_WQKV), 1024, 12, 1, 1024, 0, E); convert_in_qkv_tail(p, smem); });
                PHASE(12, phase_at_prep(p, smem));
                PHASE(13, phase_attn(p, smem, 0.8f - 0.6f * 0.7408182206817179f));
                PHASE(10, { pg8::EpiResid E; E.PB = (bf16_t*)(p.ws + OFF_R1); E.gate = MODL + 5 * 1024; E.colscale = nullptr; E.cf = cfmul;
                        run_gemm(smem, WS_H, 1024, (const bf16_t*)(p.ws + OFF_WBO), 1024, 4, 2, 512, 0, E); });
            } else {
                PHASE(14, phase_pool(p));
                PHASE(10, { pg8::EpiResid E; E.PB = (bf16_t*)(p.ws + OFF_R1); E.gate = MODL + 5 * 1024; E.colscale = p.c_scale + slot * 1024; E.cf = cfmul;
                        run_gemm(smem, WS_H, 1024, (const bf16_t*)(p.ws + OFF_WPOOL), 256, 4, 1, 256, 256, E); });
            }
        }
    }
    { const Params p = load_params(); phase_norm(p, 3, 2, p.final_g, (const float*)(p.ws + OFF_MODS), 0, 0); }
#undef PHASE
}

extern "C" void kernel_launch(void* const* d_in, const int* in_sizes, int n_in, void* d_out, int out_size, void* d_ws, size_t ws_size, hipStream_t stream) {
    static int grid = 0;
    if (grid == 0) {
        if (n_in != 26 || ws_size < WS_END) { fprintf(stderr, "kernel_launch: unexpected n_in %d or workspace %zu < %zu\n", n_in, ws_size, (size_t)WS_END); grid = -1; return; }
        int dev = 0, cus = 0, per_cu = 0;
        hipGetDevice(&dev); hipDeviceGetAttribute(&cus, hipDeviceAttributeMultiprocessorCount, dev);
        if (hipFuncSetAttribute((const void*)mega, hipFuncAttributeMaxDynamicSharedMemorySize, LDS_BYTES) != hipSuccess) { fprintf(stderr, "kernel_launch: hipFuncSetAttribute failed\n"); grid = -1; return; }
        if (hipOccupancyMaxActiveBlocksPerMultiprocessor(&per_cu, (const void*)mega, 512, LDS_BYTES) != hipSuccess || per_cu < 1) { fprintf(stderr, "kernel_launch: occupancy query says %d\n", per_cu); per_cu = 1; }
        (void)hipGetLastError();
        grid = cus;
    }
    if (grid < 0) return;
    Params p; memset(&p, 0, sizeof(p));
    const float** f = (const float**)&p;
    for (int i = 0; i < 26; ++i) f[i] = (const float*)d_in[i];
    p.out = (float*)d_out; p.ws = (unsigned char*)d_ws; p.ph_begin = 0; p.ph_end = 1000;
    void* args[] = {&p};
    hipError_t e = hipLaunchCooperativeKernel((const void*)mega, dim3(grid), dim3(512), args, LDS_BYTES, stream);
    if (e != hipSuccess) fprintf(stderr, "cooperative launch failed: %s (grid %d)\n", hipGetErrorString(e), grid);
}
```

```cpp
#include <hip/hip_runtime.h>
#include <hip/hip_cooperative_groups.h>
#include <cstdio>
#include <cstring>
namespace cg = cooperative_groups;

#define LAS __attribute__((address_space(3)))
#define GAS __attribute__((address_space(1)))
#define LDG(T, ptr) (*(const GAS T*)(ptr))
#define STG(T, ptr) (*(GAS T*)(ptr))
#define DI __device__ __forceinline__
typedef unsigned short bf16_t;
typedef short bf16x8 __attribute__((ext_vector_type(8)));
typedef short s16x4 __attribute__((ext_vector_type(4)));
typedef float f32x2 __attribute__((ext_vector_type(2)));
typedef float f32x4 __attribute__((ext_vector_type(4)));
typedef float f32x16 __attribute__((ext_vector_type(16)));
typedef unsigned u32x2 __attribute__((ext_vector_type(2)));
typedef unsigned u32x4 __attribute__((ext_vector_type(4)));

constexpr size_t SZ_WGU1 = 5632ull * 1024 * 2;
constexpr size_t SZ_WD1 = 1024ull * 2816 * 2;
constexpr size_t SZ_WIN1 = 4128ull * 1024 * 2;
constexpr size_t OFF_WGU = 0;
constexpr size_t OFF_WD = OFF_WGU + 8 * SZ_WGU1;
constexpr size_t OFF_WIN = OFF_WD + 8 * SZ_WD1;
constexpr size_t OFF_WAO = OFF_WIN + 2 * SZ_WIN1;
constexpr size_t OFF_WQKV = OFF_WAO + 2 * 2097152ull;
constexpr size_t OFF_WBO = OFF_WQKV + 3072ull * 1024 * 2;
constexpr size_t OFF_WPOOL = OFF_WBO + 2097152ull;
constexpr size_t OFF_MODS = OFF_WPOOL + 1024ull * 256 * 2;
constexpr size_t OFF_X = OFF_MODS + 110592ull * 4;
constexpr size_t OFF_H = OFF_X + 8192ull * 1024 * 4;
constexpr size_t OFF_R1 = OFF_H + 8192ull * 1024 * 2;
constexpr size_t SZ_R1 = 134217728ull;
constexpr size_t OFF_HF = OFF_R1 + 67108864ull;
constexpr size_t OFF_R2 = OFF_R1 + SZ_R1;
constexpr size_t SZ_R2 = 2048ull * 73728;
constexpr size_t OFF_ZS = OFF_R2 + SZ_R2;
constexpr size_t OFF_GB = OFF_ZS + 8192ull * 1024 * 2;
constexpr size_t OFF_GL = OFF_GB + 8192ull * 32 * 4;
constexpr size_t OFF_BAR = OFF_GL + 8192;
constexpr size_t WS_END = OFF_BAR + 16384;
constexpr size_t CL_STRIDE = 73728, CL_WN = 0, CL_QG = 16384, CL_KD = 32768, CL_AT = 49152, CL_U = 57344;
constexpr size_t A_QB = 0;
constexpr size_t A_KS = A_QB + 8192ull * 1024 * 2;
constexpr size_t A_KP = A_KS + 2ull * 8 * 2304 * 128 * 2;
constexpr size_t A_VTS = A_KP + 16ull * 8 * 256 * 128 * 2;
constexpr size_t A_VTP = A_VTS + 2ull * 8 * 128 * 2304 * 2;
constexpr int LDS_BYTES = 147456;
constexpr unsigned DUP_MASK = 0x00000u;
constexpr float EPSF = 1e-6f;

struct Params {
    const float *x_prompt, *x_sample, *state_a, *cache_k, *cache_v, *c, *c_ctx, *w_mod, *b_mod, *norm_g, *ffn_wg, *ffn_wu, *ffn_wd, *a_w_in, *a_conv, *a_A_log, *a_dt_bias,
        *a_norm_g, *a_w_out, *b_w_qkv, *b_lam, *b_norm_g, *b_w_out, *c_w_pool, *c_scale, *final_g;
    float* out;
    unsigned char* ws;
    int ph_begin, ph_end;
};

DI int opq_tid() { const int w = __builtin_amdgcn_readfirstlane((int)threadIdx.x >> 6); const int l = __builtin_amdgcn_mbcnt_hi(~0u, __builtin_amdgcn_mbcnt_lo(~0u, 0u));
    int t = (w << 6) | l; asm volatile("" : "+v"(t)); return t; }
DI int opq_bid() { int t = blockIdx.x; asm volatile("" : "+s"(t)); return t; }
DI int opq_gdim() { int t = gridDim.x; asm volatile("" : "+s"(t)); return t; }
typedef __bf16 hwbf16x2 __attribute__((ext_vector_type(2)));
DI unsigned cvt_pk_bf16(float lo, float hi) { f32x2 v = {lo, hi}; hwbf16x2 b = __builtin_convertvector(v, hwbf16x2); return __builtin_bit_cast(unsigned, b); }
DI bf16_t to_bf16(float v) { return (bf16_t)(cvt_pk_bf16(v, v) & 0xffffu); }
DI float bf16_to_f(bf16_t b) { return __uint_as_float(((unsigned)b) << 16); }
DI int opq_lane() { int l = __builtin_amdgcn_mbcnt_hi(~0u, __builtin_amdgcn_mbcnt_lo(~0u, 0u)); asm volatile("" : "+v"(l)); return l; }
DI float shfl_lane(float v, int src) { return __int_as_float(__builtin_amdgcn_ds_bpermute(src << 2, __float_as_int(v))); }
DI float wave_sum(float v) {
    const int l = opq_lane();
#pragma unroll
    for (int o = 1; o < 64; o <<= 1) v += shfl_lane(v, l ^ o);
    return v;
}
DI float silu_f(float x) { return x * __builtin_amdgcn_rcpf(1.0f + __expf(-x)); }
DI float sigmoid_f(float x) { return 1.0f / (1.0f + expf(-x)); }
DI float softplus_f(float x) { return fmaxf(x, 0.f) + log1pf(expf(-fabsf(x))); }
#define LDSBAR() do { asm volatile("s_waitcnt lgkmcnt(0)" ::: "memory"); __builtin_amdgcn_s_barrier(); asm volatile("" ::: "memory"); } while (0)
DI int frag128(int row, int k) { return ((((row >> 5) * 8 + (k >> 4)) * 64 + ((k >> 3) & 1) * 32 + (row & 31)) << 3) + (k & 7); }
DI int frag64(int row, int k) { return ((((row >> 5) * 4 + (k >> 4)) * 64 + ((k >> 3) & 1) * 32 + (row & 31)) << 3) + (k & 7); }
template <int OFF> DI void gld16(u32x4& d, const void* p) { asm volatile("global_load_dwordx4 %0, %1, off offset:%2" : "=v"(d) : "v"(p), "n"(OFF) : "memory"); }
DI void gld4(float& d, const void* p) { asm volatile("global_load_dword %0, %1, off" : "=v"(d) : "v"(p) : "memory"); }
DI int crow(int reg, int h) { return (reg & 3) + 8 * (reg >> 2) + 4 * h; }
DI int row_cond(int r) { return r < 4096 ? 0 : 1 + ((r - 4096) >> 11); }

namespace pg8 {
constexpr int BM = 256, BK = 64, HALF = 128, HTB = HALF * BK * 2, STAGE_BYTES = 8 * HTB;
DI int lds_byte(int r, int c) { const int st = (r >> 4) * 2 + (c >> 5), rr = r & 15, cc = c & 31, ob = rr * 64 + cc * 2; return st * 1024 + (ob ^ (((ob >> 9) & 1) << 5)); }
DI void stage_rc(int b, int& R, int& C) { const int st = b / 1024, sb = b % 1024, swz = sb ^ (((sb >> 9) & 1) << 5); R = (st >> 1) * 16 + swz / 64; C = (st & 1) * 32 + (swz % 64) / 2; }
DI int perm32(int rho) { const int n = rho >> 4, i = rho & 15; return 8 * (i >> 2) + 4 * n + (i & 3); }
struct Unit { int pm, pn, ka, kb; };
struct Gemm { const bf16_t* A; const bf16_t* Bt; int lda, ldb, nt; };
struct Sched {
    int nM, nNv, nwg, G, c, nS, kper, apn;
    DI void init(int nM_, int nN_, int nS_, int kper_, int apn_, int G_, int c_) { nM = nM_; nNv = nN_ * nS_; nS = nS_; kper = kper_; apn = apn_; nwg = nM * nNv; G = G_; c = c_; }
    DI bool next(int i, Unit& u) const {
        const long L = (long)i * G + c; if (L >= nwg) return false;
        int wgid = (int)L; { const int q = nwg / 8, r = nwg % 8, xcd = wgid % 8, off = wgid / 8; wgid = (xcd < r ? xcd * (q + 1) : r * (q + 1) + (xcd - r) * q) + off; }
        const int nig = 8 * nNv, gid = wgid / nig, fm = gid * 8, gsz = (nM - fm) < 8 ? (nM - fm) : 8;
        u.pm = fm + ((wgid % nig) % gsz); const int pnv = (wgid % nig) / gsz;
        u.pn = pnv / nS; const int ks = pnv % nS; u.ka = ks * kper + u.pn * apn; u.kb = ks * kper; return true;
    }
};

struct EpiF32 {
    static constexpr bool PERM = false;
    float* C; int ldc;
    DI void operator()(const f32x4 (&acc)[2][2][4][2], const Unit& u, int wr, int wc, int fr, int fq) const {
        const int row0 = u.pm * BM + wr * 64 + fr, col0 = u.pn * BM + wc * 32 + 4 * fq;
#pragma unroll
        for (int ai = 0; ai < 2; ++ai)
#pragma unroll
            for (int m = 0; m < 4; ++m) { float* rowp = C + (size_t)(row0 + ai * HALF + m * 16) * ldc + col0;
#pragma unroll
                for (int bj = 0; bj < 2; ++bj)
#pragma unroll
                    for (int n = 0; n < 2; ++n) STG(f32x4, rowp + bj * HALF + n * 16) = acc[ai][bj][m][n]; }
    }
};
struct EpiSwiglu {
    static constexpr bool PERM = true;
    bf16_t* O;
    DI void operator()(const f32x4 (&acc)[2][2][4][2], const Unit& u, int wr, int wc, int fr, int fq) const {
        const int row0 = u.pm * BM + wr * 64 + fr, col0 = u.pn * 128 + wc * 32 + 8 * fq;
#pragma unroll
        for (int ai = 0; ai < 2; ++ai)
#pragma unroll
            for (int m = 0; m < 4; ++m) { bf16_t* rowp = O + (size_t)(row0 + ai * HALF + m * 16) * 2816 + col0;
                float v[8];
#pragma unroll
                for (int n = 0; n < 2; ++n)
#pragma unroll
                    for (int j = 0; j < 4; ++j) v[n * 4 + j] = silu_f(acc[ai][0][m][n][j]) * acc[ai][1][m][n][j];
                u32x4 w; w.x = cvt_pk_bf16(v[0], v[1]); w.y = cvt_pk_bf16(v[2], v[3]); w.z = cvt_pk_bf16(v[4], v[5]); w.w = cvt_pk_bf16(v[6], v[7]);
                STG(u32x4, rowp) = w; }
    }
};
struct EpiResid {
    static constexpr bool PERM = true;
    bf16_t* PB; const float* gate; const float* colscale; float cf;
    DI void operator()(const f32x4 (&acc)[2][2][4][2], const Unit& u, int wr, int wc, int fr, int fq) const {
        const int row0 = u.pm * BM + wr * 64 + fr, col0 = u.pn * BM + wc * 32 + 8 * fq;
        const int cond = u.pm < 16 ? 0 : (u.pm < 24 ? 1 : 2);
        bf16_t* P = PB + (u.kb ? (size_t)8388608 : (size_t)0);
        f32x4 gv[2][2];
#pragma unroll
        for (int bj = 0; bj < 2; ++bj)
#pragma unroll
            for (int n = 0; n < 2; ++n) { const int cc = col0 + bj * HALF + n * 4; f32x4 g = LDG(f32x4, gate + cond * 9216 + cc) * cf;
                if (colscale) g = g * LDG(f32x4, colscale + cc); gv[bj][n] = g; }
#pragma unroll
        for (int ai = 0; ai < 2; ++ai)
#pragma unroll
            for (int m = 0; m < 4; ++m) { bf16_t* rowp = P + (size_t)(row0 + ai * HALF + m * 16) * 1024 + col0;
#pragma unroll
                for (int bj = 0; bj < 2; ++bj) { const f32x4 v0 = acc[ai][bj][m][0] * gv[bj][0], v1 = acc[ai][bj][m][1] * gv[bj][1];
                    u32x4 w; w.x = cvt_pk_bf16(v0[0], v0[1]); w.y = cvt_pk_bf16(v0[2], v0[3]); w.z = cvt_pk_bf16(v1[0], v1[1]); w.w = cvt_pk_bf16(v1[2], v1[3]);
                    STG(u32x4, rowp + bj * HALF) = w; } }
    }
};

template <class Epi>
DI void gemm_phase(LAS unsigned char* lds, const Gemm g, const Sched& S, const Epi& E) {
    const int tid = opq_tid(), wid = __builtin_amdgcn_readfirstlane(tid >> 6), lane = tid & 63, wr = wid >> 2, wc = wid & 3, fr = lane & 15, fq = lane >> 4;
    const int nt = g.nt;
    unsigned voffA[2], voffB[2];
#pragma unroll
    for (int i = 0; i < 2; ++i) { int R, C; stage_rc(tid * 16 + i * 8192, R, C); const int Rb = Epi::PERM ? ((R & ~31) + perm32(R & 31)) : R;
        voffA[i] = (unsigned)(R * g.lda + C) * 2u; voffB[i] = (unsigned)(Rb * g.ldb + C) * 2u; }
    const size_t kstep = (size_t)(BK * 2);
    const size_t hstepA = (size_t)HALF * g.lda * 2, hstepB = (size_t)HALF * g.ldb * 2;
    const unsigned ldsw = (unsigned)wid * 1024u;
    const int aoff = lds_byte(wr * 64 + fr, fq * 8), boff = lds_byte(wc * 32 + fr, fq * 8);
#define PG8_SA(b, h) (((b) * 2 + (h)) * HTB)
#define PG8_SB(b, h) ((4 + (b) * 2 + (h)) * HTB)
#define PG8_STAGE(bufoff, gbase, voff) do { _Pragma("unroll") for (int _i = 0; _i < 2; ++_i) \
        __builtin_amdgcn_global_load_lds((const unsigned*)((const char*)(gbase) + (voff)[_i]), (LAS unsigned*)(lds + (bufoff) + ldsw + _i * 8192), 16, 0, 0); } while (0)
#define PG8_LDA(dst, b, h) do { _Pragma("unroll") for (int m = 0; m < 4; ++m) _Pragma("unroll") for (int k = 0; k < 2; ++k) dst[m][k] = *(const LAS bf16x8*)(lds + PG8_SA(b, h) + aoff + m * 2048 + k * 1024); } while (0)
#define PG8_LDB(dst, b, h) do { _Pragma("unroll") for (int n = 0; n < 2; ++n) _Pragma("unroll") for (int k = 0; k < 2; ++k) dst[n][k] = *(const LAS bf16x8*)(lds + PG8_SB(b, h) + boff + n * 2048 + k * 1024); } while (0)
#define PG8_MMA(ai, bj, At, Bt) do { __builtin_amdgcn_s_setprio(1); _Pragma("unroll") for (int m = 0; m < 4; ++m) _Pragma("unroll") for (int n = 0; n < 2; ++n) _Pragma("unroll") for (int k = 0; k < 2; ++k) \
        acc[ai][bj][m][n] = __builtin_amdgcn_mfma_f32_16x16x32_bf16(Bt[n][k], At[m][k], acc[ai][bj][m][n], 0, 0, 0); __builtin_amdgcn_s_setprio(0); } while (0)
#define PG8_WAIT_V(n) asm volatile("s_waitcnt vmcnt(" #n ")" ::: "memory")
#define PG8_WAIT_L(n) asm volatile("s_waitcnt lgkmcnt(" #n ")" ::: "memory")
#define PG8_BAR __builtin_amdgcn_s_barrier()
#define PG8_SCHED __builtin_amdgcn_sched_barrier(0)
    Unit cur, nxt; int ui = 0;
    if (!S.next(0, cur)) return;
    f32x4 acc[2][2][4][2];
#pragma unroll
    for (int a = 0; a < 2; ++a)
#pragma unroll
        for (int b = 0; b < 2; ++b)
#pragma unroll
            for (int m = 0; m < 4; ++m)
#pragma unroll
                for (int n = 0; n < 2; ++n) acc[a][b][m][n] = (f32x4){0.f, 0.f, 0.f, 0.f};
    bf16x8 At[4][2], B0[2][2], B1[2][2];
    const char* cA = (const char*)g.A + ((size_t)cur.pm * BM * g.lda + cur.ka) * 2; const char* cB = (const char*)g.Bt + ((size_t)cur.pn * BM * g.ldb + cur.kb) * 2;
    PG8_STAGE(PG8_SB(0, 0), cB, voffB); PG8_STAGE(PG8_SB(0, 1), cB + hstepB, voffB); PG8_STAGE(PG8_SA(0, 0), cA, voffA); PG8_STAGE(PG8_SA(0, 1), cA + hstepA, voffA);
    if (wr == 1) PG8_BAR;
    PG8_WAIT_V(2); PG8_BAR;
    PG8_STAGE(PG8_SB(1, 0), cB + kstep, voffB); PG8_STAGE(PG8_SA(1, 0), cA + kstep, voffA); PG8_STAGE(PG8_SB(1, 1), cB + hstepB + kstep, voffB);
    PG8_WAIT_V(6); PG8_BAR;
    for (;;) {
        const bool has_next = S.next(ui + 1, nxt);
        const char* nA = has_next ? (const char*)g.A + ((size_t)nxt.pm * BM * g.lda + nxt.ka) * 2 : cA; const char* nB = has_next ? (const char*)g.Bt + ((size_t)nxt.pn * BM * g.ldb + nxt.kb) * 2 : cB;
        for (int t = 0; t < nt; t += 2) {
            const bool last = (t == nt - 2);
            const char* a1 = cA + (size_t)(t + 1) * kstep;
            const char* a2 = last ? nA : cA + (size_t)(t + 2) * kstep; const char* b2 = last ? nB : cB + (size_t)(t + 2) * kstep;
            const char* a3 = a2 + kstep; const char* b3 = b2 + kstep;
            PG8_LDB(B0, 0, 0); PG8_LDB(B1, 0, 1); PG8_SCHED; PG8_LDA(At, 0, 0); PG8_STAGE(PG8_SA(1, 1), a1 + hstepA, voffA);
            PG8_WAIT_V(8); PG8_WAIT_L(0); PG8_BAR; PG8_MMA(0, 0, At, B0); PG8_MMA(0, 1, At, B1); PG8_BAR; PG8_SCHED;
            PG8_LDA(At, 0, 1); PG8_STAGE(PG8_SB(0, 0), b2, voffB); PG8_STAGE(PG8_SB(0, 1), b2 + hstepB, voffB); PG8_STAGE(PG8_SA(0, 0), a2, voffA);
            PG8_WAIT_V(8); PG8_WAIT_L(0); PG8_BAR; PG8_MMA(1, 0, At, B0); PG8_MMA(1, 1, At, B1); PG8_BAR; PG8_SCHED;
            PG8_LDB(B0, 1, 0); PG8_LDB(B1, 1, 1); PG8_SCHED; PG8_LDA(At, 1, 0); PG8_STAGE(PG8_SA(0, 1), a2 + hstepA, voffA);
            PG8_WAIT_V(8); PG8_WAIT_L(0); PG8_BAR; PG8_MMA(0, 0, At, B0); PG8_MMA(0, 1, At, B1); PG8_BAR; PG8_SCHED;
            PG8_LDA(At, 1, 1); PG8_STAGE(PG8_SB(1, 0), b3, voffB); PG8_STAGE(PG8_SB(1, 1), b3 + hstepB, voffB); PG8_STAGE(PG8_SA(1, 0), a3, voffA);
            PG8_WAIT_V(8); PG8_WAIT_L(0); PG8_BAR; PG8_MMA(1, 0, At, B0); PG8_MMA(1, 1, At, B1); PG8_BAR; PG8_SCHED;
        }
        if (wr == 0) PG8_BAR;
        E(acc, cur, wr, wc, fr, fq);
        if (!has_next) break;
#pragma unroll
        for (int a = 0; a < 2; ++a)
#pragma unroll
            for (int b = 0; b < 2; ++b)
#pragma unroll
                for (int m = 0; m < 4; ++m)
#pragma unroll
                    for (int n = 0; n < 2; ++n) acc[a][b][m][n] = (f32x4){0.f, 0.f, 0.f, 0.f};
        cur = nxt; cA = nA; cB = nB; ++ui;
        if (wr == 1) PG8_BAR;
    }
    PG8_WAIT_V(0);
    PG8_BAR;
#undef PG8_SA
#undef PG8_SB
#undef PG8_STAGE
#undef PG8_LDA
#undef PG8_LDB
#undef PG8_MMA
#undef PG8_WAIT_V
#undef PG8_WAIT_L
#undef PG8_BAR
#undef PG8_SCHED
}
}

template <class Epi>
DI void run_gemm(unsigned char* smem, const bf16_t* A, int lda, const bf16_t* Bt, int ldb, int nN, int nS, int kper, int apn, const Epi& E) {
    pg8::Gemm g; g.A = A; g.Bt = Bt; g.lda = lda; g.ldb = ldb; g.nt = kper / 64;
    pg8::Sched S; S.init(32, nN, nS, kper, apn, (int)opq_gdim(), (int)opq_bid());
    pg8::gemm_phase<Epi>((LAS unsigned char*)smem, g, S, E);
}

DI int rowmap(int n, int mode) { return mode == 0 ? n : ((n >> 7) * 256 + (n & 127) + (mode == 2 ? 128 : 0)); }
DI void tr_item(const float* W, int K, int N, bf16_t* WT, int mode, float* scr, int item, int lane) {
    const int nblk = N / 32, kb = item / nblk, nb = item % nblk, k0 = 64 * kb, n0 = 32 * nb;
    float wv[32];
#pragma unroll
    for (int i = 0; i < 32; ++i) wv[i] = LDG(float, W + (size_t)(k0 + 2 * i + (lane >> 5)) * N + n0 + (lane & 31));
#pragma unroll
    for (int i = 0; i < 32; ++i) scr[(2 * i + (lane >> 5)) * 33 + (lane & 31)] = wv[i];
    __builtin_amdgcn_fence(__ATOMIC_RELEASE, "wavefront"); __builtin_amdgcn_wave_barrier(); __builtin_amdgcn_fence(__ATOMIC_ACQUIRE, "wavefront");
    const int c = lane & 7;
#pragma unroll
    for (int j = 0; j < 4; ++j) { const int n = (lane >> 3) + 8 * j; const float* s = scr + (8 * c) * 33 + n;
        u32x4 o; o.x = cvt_pk_bf16(s[0 * 33], s[1 * 33]); o.y = cvt_pk_bf16(s[2 * 33], s[3 * 33]); o.z = cvt_pk_bf16(s[4 * 33], s[5 * 33]); o.w = cvt_pk_bf16(s[6 * 33], s[7 * 33]);
        STG(u32x4, WT + (size_t)rowmap(n0 + n, mode) * K + k0 + 8 * c) = o; }
    __builtin_amdgcn_fence(__ATOMIC_RELEASE, "wavefront"); __builtin_amdgcn_wave_barrier(); __builtin_amdgcn_fence(__ATOMIC_ACQUIRE, "wavefront");
}
DI void phase_convert_layer(const Params& p, unsigned char* smem, int L, int klo, int khi, int gw, int NGW) {
    const int lane = opq_tid() & 63, wave = opq_tid() >> 6;
    float* scr = (float*)smem + wave * (64 * 33);
    constexpr int I_F = 1408, I_L = 6 * I_F, I_IN = 16 * 129, I_SQ = 512, I_QKV = 1536, I_PL = 32;
    const int nL = I_L + (L == 1 ? I_QKV + I_SQ : (L == 2 ? 4 * I_PL : I_IN + I_SQ));
    if (khi > nL) khi = nL;
    for (int k = klo + gw; k < khi; k += NGW) {
        int r = k;
        if (r < I_L) { const int idx = 2 * L + r / (3 * I_F), q = r % (3 * I_F), which = q / I_F, item = q % I_F;
            if (which == 0) tr_item(p.ffn_wg + (size_t)idx * 1024 * 2816, 1024, 2816, (bf16_t*)(p.ws + OFF_WGU + idx * SZ_WGU1), 1, scr, item, lane);
            else if (which == 1) tr_item(p.ffn_wu + (size_t)idx * 1024 * 2816, 1024, 2816, (bf16_t*)(p.ws + OFF_WGU + idx * SZ_WGU1), 2, scr, item, lane);
            else tr_item(p.ffn_wd + (size_t)idx * 2816 * 1024, 2816, 1024, (bf16_t*)(p.ws + OFF_WD + idx * SZ_WD1), 0, scr, item, lane);
            continue; }
        r -= I_L;
        if (L == 1) { if (r < I_QKV) tr_item(p.b_w_qkv, 1024, 3072, (bf16_t*)(p.ws + OFF_WQKV), 0, scr, r, lane); else tr_item(p.b_w_out, 1024, 1024, (bf16_t*)(p.ws + OFF_WBO), 0, scr, r - I_QKV, lane); }
        else if (L == 2) { const int gI = r / I_PL; tr_item(p.c_w_pool + (size_t)gI * 65536, 256, 256, (bf16_t*)(p.ws + OFF_WPOOL) + (size_t)gI * 65536, 0, scr, r % I_PL, lane); }
        else { const int sl = L / 3;
            if (r < I_IN) tr_item(p.a_w_in + (size_t)sl * 1024 * 4128, 1024, 4128, (bf16_t*)(p.ws + OFF_WIN + sl * SZ_WIN1), 0, scr, r, lane);
            else tr_item(p.a_w_out + (size_t)sl * 1024 * 1024, 1024, 1024, (bf16_t*)(p.ws + OFF_WAO + sl * 2097152ull), 0, scr, r - I_IN, lane); }
    }
}
DI void phase_convert(const Params& p, unsigned char* smem) { phase_convert_layer(p, smem, 0, 0, 1 << 30, opq_bid() * 8 + (opq_tid() >> 6), opq_gdim() * 8); }
DI void convert_in_gemm_tail(const Params& p, unsigned char* smem, int layer, int part) {
    const int G = opq_gdim(), tail0 = 704 % G, bid = opq_bid();
    if (bid < tail0) return;
    const int gw = (bid - tail0) * 8 + (opq_tid() >> 6), NGW = (G - tail0) * 8;
    if (layer == 0 && part == 0) phase_convert_layer(p, smem, 1, 0, 3136, gw, NGW);
    else if (layer == 0) { phase_convert_layer(p, smem, 1, 3136, 4224, gw, NGW); phase_convert_layer(p, smem, 1, 8448, 10496, gw, NGW); }
    else if (layer == 1 && part == 0) phase_convert_layer(p, smem, 1, 4224, 8448, gw, NGW);
    else if (layer == 1) phase_convert_layer(p, smem, 3, 0, 3675, gw, NGW);
    else if (layer == 2 && part == 0) phase_convert_layer(p, smem, 3, 3675, 7350, gw, NGW);
    else if (layer == 2) phase_convert_layer(p, smem, 3, 7350, 11024, gw, NGW);
}
DI void convert_in_qkv_tail(const Params& p, unsigned char* smem) {
    const int G = opq_gdim(), tail0 = 384 % G, bid = opq_bid();
    if (G >= 384) { phase_convert_layer(p, smem, 2, 0, 1 << 30, bid * 8 + (opq_tid() >> 6), G * 8); return; }
    if (bid < tail0) return;
    phase_convert_layer(p, smem, 2, 0, 1 << 30, (bid - tail0) * 8 + (opq_tid() >> 6), (G - tail0) * 8);
}
DI void phase_modpart(const Params& p, unsigned char* smem) {
    float* sS = (float*)smem;
    float* sR = sS + 192;
    float* mpart = (float*)(p.ws + OFF_R1);
    const int t = opq_tid(), cgI = t & 255, kh = t >> 8;
    for (int task = opq_bid(); task < 576; task += opq_gdim()) {
        const int layer = task / 144, rem = task % 144, nc = rem / 16, kc = rem % 16;
        __syncthreads();
        if (t < 192) { const int cc = t / 64, kk = t % 64, k = kc * 64 + kk; const float v = cc == 0 ? p.c_ctx[k] : p.c[(cc - 1) * 1024 + k]; sS[t] = v / (1.0f + expf(-v)); }
        __syncthreads();
        f32x4 a0 = {0, 0, 0, 0}, a1 = a0, a2 = a0;
        const float* wp = p.w_mod + ((size_t)layer * 1024 + kc * 64 + kh * 32) * 9216 + nc * 1024 + cgI * 4;
#pragma unroll 8
        for (int i = 0; i < 32; ++i) { const f32x4 w = LDG(f32x4, wp + (size_t)i * 9216); const int kk = kh * 32 + i;
            a0 += w * sS[kk]; a1 += w * sS[64 + kk]; a2 += w * sS[128 + kk]; }
        if (kh == 1) { float* q = sR + cgI * 12; *(f32x4*)q = a0; *(f32x4*)(q + 4) = a1; *(f32x4*)(q + 8) = a2; }
        __syncthreads();
        if (kh == 0) { const float* q = sR + cgI * 12; a0 += *(const f32x4*)q; a1 += *(const f32x4*)(q + 4); a2 += *(const f32x4*)(q + 8);
            float* o = mpart + ((size_t)(kc * 4 + layer) * 3) * 9216 + nc * 1024 + cgI * 4;
            *(f32x4*)o = a0; *(f32x4*)(o + 9216) = a1; *(f32x4*)(o + 2 * 9216) = a2; }
    }
}
DI void phase_modreduce(const Params& p) {
    const float* mpart = (const float*)(p.ws + OFF_R1); float* mods = (float*)(p.ws + OFF_MODS);
    for (int i = opq_bid() * 512 + opq_tid(); i < 110592; i += opq_gdim() * 512) {
        const int layer = i / 27648, n = i % 9216; float s = p.b_mod[layer * 9216 + n];
#pragma unroll
        for (int kc = 0; kc < 16; ++kc) s += mpart[(size_t)kc * 110592 + i];
        mods[i] = s;
    }
}

DI void phase_norm(const Params& p, int mode, int nparts, const float* g, const float* modl, int jshift, int jscale) {
    const int lane = opq_tid() & 63, gw = opq_bid() * 8 + (opq_tid() >> 6), NGW = opq_gdim() * 8;
    float* X = (float*)(p.ws + OFF_X); bf16_t* H = (bf16_t*)(p.ws + OFF_H); float* HF = (float*)(p.ws + OFF_HF); const bf16_t* PB = (const bf16_t*)(p.ws + OFF_R1);
    for (int r0 = gw; r0 < 8192; r0 += 2 * NGW) {
        f32x4 v[2][4]; float ss[2] = {0.f, 0.f};
#pragma unroll
        for (int q = 0; q < 2; ++q) { const int r = r0 + q * NGW; if (r < 8192) {
            const float* src = mode == 1 ? (r < 4096 ? p.x_prompt + (size_t)r * 1024 : p.x_sample + (size_t)(r - 4096) * 1024) : X + (size_t)r * 1024;
#pragma unroll
            for (int j = 0; j < 4; ++j) { const int cc = lane * 4 + 256 * j; v[q][j] = LDG(f32x4, src + cc);
                if (nparts > 0) { const u32x2 w = LDG(u32x2, PB + (size_t)r * 1024 + cc); v[q][j] += (f32x4){__uint_as_float(w.x << 16), __uint_as_float(w.x & 0xffff0000u), __uint_as_float(w.y << 16), __uint_as_float(w.y & 0xffff0000u)}; }
                if (nparts > 1) { const u32x2 w = LDG(u32x2, PB + 8388608 + (size_t)r * 1024 + cc); v[q][j] += (f32x4){__uint_as_float(w.x << 16), __uint_as_float(w.x & 0xffff0000u), __uint_as_float(w.y << 16), __uint_as_float(w.y & 0xffff0000u)}; }
                ss[q] += v[q][j].x * v[q][j].x + v[q][j].y * v[q][j].y + v[q][j].z * v[q][j].z + v[q][j].w * v[q][j].w; } } }
#pragma unroll
        for (int q = 0; q < 2; ++q) { const int r = r0 + q * NGW; if (r < 8192) {
            const float rstd = rsqrtf(wave_sum(ss[q]) * (1.0f / 1024.f) + EPSF);
            const int cond = row_cond(r);
#pragma unroll
            for (int j = 0; j < 4; ++j) { const int cc = lane * 4 + 256 * j; const f32x4 gg = LDG(f32x4, g + cc);
                f32x4 y = v[q][j] * rstd * gg;
                if (mode != 3) { const f32x4 sc = LDG(f32x4, modl + cond * 9216 + jscale * 1024 + cc), sh = LDG(f32x4, modl + cond * 9216 + jshift * 1024 + cc);
                    y = y * (sc + 1.0f) + sh;
                    u32x2 w; w.x = cvt_pk_bf16(y.x, y.y); w.y = cvt_pk_bf16(y.z, y.w); STG(u32x2, H + (size_t)r * 1024 + cc) = w;
                    if (mode == 1 || nparts > 0) STG(f32x4, X + (size_t)r * 1024 + cc) = v[q][j];
                    if (mode == 2) STG(f32x4, HF + (size_t)r * 1024 + cc) = y;
                } else STG(f32x4, p.out + (size_t)r * 1024 + cc) = y; } } }
    }
}

DI void seq_of_row(int r, int& row0, int& pos, int& L) { if (r < 4096) { row0 = r & ~255; pos = r & 255; L = 256; } else { const int q = r - 4096; row0 = 4096 + (q & ~2047); pos = q & 2047; L = 2048; } }
DI void phase_dn_gates(const Params& p, int slot) {
    const int lane = opq_tid() & 63, gw = opq_bid() * 8 + (opq_tid() >> 6), NGW = opq_gdim() * 8;
    float* GB = (float*)(p.ws + OFF_GB);
    const bf16_t* H = (const bf16_t*)(p.ws + OFF_H); const bf16_t* WAB = (const bf16_t*)(p.ws + OFF_WIN + slot * SZ_WIN1) + (size_t)4096 * 1024;
    for (int task = gw; task < 512; task += NGW) {
        const int r0 = task * 16; f32x4 c0 = {0, 0, 0, 0}, c1 = c0;
        const bf16_t* ap = H + (size_t)(r0 + (lane & 15)) * 1024 + (lane >> 4) * 8; const bf16_t* bp = WAB + (size_t)(lane & 15) * 1024 + (lane >> 4) * 8;
#pragma unroll 8
        for (int ks = 0; ks < 32; ++ks) { const bf16x8 a = *(const bf16x8*)(ap + ks * 32), b0 = *(const bf16x8*)(bp + ks * 32), b1 = *(const bf16x8*)(bp + 16 * 1024 + ks * 32);
            c0 = __builtin_amdgcn_mfma_f32_16x16x32_bf16(a, b0, c0, 0, 0, 0); c1 = __builtin_amdgcn_mfma_f32_16x16x32_bf16(a, b1, c1, 0, 0, 0); }
        const int col = lane & 15, which = col >> 3, head = col & 7;
#pragma unroll
        for (int dir = 0; dir < 2; ++dir) { const float al = expf(p.a_A_log[slot * 16 + dir * 8 + head]), db = p.a_dt_bias[slot * 16 + dir * 8 + head];
#pragma unroll
            for (int j = 0; j < 4; ++j) { const float v = dir ? c1[j] : c0[j]; const float o = which == 0 ? -al * softplus_f(v + db) : sigmoid_f(v);
                GB[(size_t)(r0 + (lane >> 4) * 4 + j) * 32 + dir * 16 + col] = o; } }
    }
}
DI void cl_decode(int cp, int& row0, int& L, int& chunk, int& cpb, int& nch) { if (cp < 64) { row0 = (cp >> 2) * 256; L = 256; chunk = cp & 3; cpb = cp & ~3; nch = 4; } else { const int cs = cp - 64; row0 = 4096 + (cs >> 5) * 2048; L = 2048; chunk = cs & 31; cpb = 64 + (cs & ~31); nch = 32; } }
DI void phase_dn_chunk(const Params& p, unsigned char* smem, int slot) {
    float* Ks = (float*)smem; float* Qs = Ks + 64 * 129; float* Vs = Qs + 64 * 129; float* Lm0 = Vs + 64 * 129; float* Lm1 = Lm0 + 64 * 68; float* gcs = Lm1 + 64 * 68; float* bes = gcs + 128; float* egs = bes + 128;
    const float* PROJ = (const float*)(p.ws + OFF_R1); const float* GB = (const float*)(p.ws + OFF_GB); bf16_t* ZS = (bf16_t*)(p.ws + OFF_ZS);
    float* GL = (float*)(p.ws + OFF_GL); const float* cw = p.a_conv + (size_t)slot * 5 * 3072;
    for (int task = opq_bid(); task < 1024; task += opq_gdim()) {
        const int t = opq_tid(), lane = t & 63, wave = t >> 6, h = lane >> 5;
        const int head = task & 7, cp = task >> 3; int row0, L, chunk, cpb, nch; cl_decode(cp, row0, L, chunk, cpb, nch);
        unsigned char* rec0 = p.ws + OFF_R2 + (size_t)(((cpb + chunk) * 8 + head) * 2 + 0) * CL_STRIDE;
        unsigned char* rec1 = p.ws + OFF_R2 + (size_t)(((cpb + nch - 1 - chunk) * 8 + head) * 2 + 1) * CL_STRIDE;
        __syncthreads();
        {
            const int c = t & 127, i0 = (t >> 7) * 16, pos0 = 64 * chunk + i0;
#pragma unroll
            for (int tz = 0; tz < 3; ++tz) { const int cb = tz * 1024 + head * 128 + c; float x[20], w[5];
#pragma unroll
                for (int j = 0; j < 5; ++j) w[j] = LDG(float, cw + j * 3072 + cb);
#pragma unroll
                for (int m = 0; m < 20; ++m) { const int pp = pos0 - 2 + m; x[m] = (pp >= 0 && pp < L) ? LDG(float, PROJ + (size_t)(row0 + pp) * 4096 + cb) : 0.f; }
                float* dst = (tz == 0 ? Qs : (tz == 1 ? Ks : Vs)) + i0 * 129 + c;
#pragma unroll
                for (int k = 0; k < 16; ++k) { const float v = x[k] * w[0] + x[k + 1] * w[1] + x[k + 2] * w[2] + x[k + 3] * w[3] + x[k + 4] * w[4]; dst[k * 129] = silu_f(v); } }
            { const float* zr = PROJ + (size_t)(row0 + pos0) * 4096 + 3072 + head * 128 + c; bf16_t* zd = ZS + (size_t)(row0 + pos0) * 1024 + head * 128 + c; float z[16];
#pragma unroll
              for (int k = 0; k < 16; ++k) z[k] = LDG(float, zr + (size_t)k * 4096);
#pragma unroll
              for (int k = 0; k < 16; ++k) STG(bf16_t, zd + (size_t)k * 1024) = to_bf16(silu_f(z[k])); }
            if (t < 128) { const int d = t >> 6, io = d ? 63 - lane : lane; const size_t gi = (size_t)(row0 + 64 * chunk + io) * 32 + d * 16 + head;
                float s2 = LDG(float, GB + gi); bes[t] = LDG(float, GB + gi + 8);
#pragma unroll
                for (int o = 1; o < 64; o <<= 1) { const float u = shfl_lane(s2, lane >= o ? lane - o : lane); if (lane >= o) s2 += u; }
                gcs[t] = s2; egs[t] = __expf(s2);
                if (lane == 63) STG(float, GL + ((cpb + (d ? nch - 1 - chunk : chunk)) * 8 + head) * 2 + d) = __expf(s2); }
        }
        __syncthreads();
        {
            const int i = t >> 3, sg = (t & 7) * 16;
#pragma unroll
            for (int tz = 0; tz < 2; ++tz) { float* row = (tz == 0 ? Qs : Ks) + i * 129 + sg; float v[16]; float ss = 0.f;
#pragma unroll
                for (int k = 0; k < 16; ++k) { v[k] = row[k]; ss += v[k] * v[k]; }
                ss += shfl_lane(ss, lane ^ 1); ss += shfl_lane(ss, lane ^ 2); ss += shfl_lane(ss, lane ^ 4);
                float sc = rsqrtf(ss + EPSF); if (tz == 0) sc *= 0.08838834764831845f;
#pragma unroll
                for (int k = 0; k < 16; ++k) row[k] = v[k] * sc; }
        }
        __syncthreads();
        {
          const int pr = wave >> 2, ti = (wave >> 1) & 1, tj = wave & 1; const float* Xs = pr ? Qs : Ks;
          f32x16 acc; for (int i = 0; i < 16; ++i) acc[i] = 0.f;
          const float* ap = Xs + (32 * ti + (lane & 31)) * 129 + h; const float* bp = Ks + (32 * tj + (lane & 31)) * 129 + h;
#pragma unroll 8
          for (int s2 = 0; s2 < 64; ++s2) acc = __builtin_amdgcn_mfma_f32_32x32x2f32(ap[2 * s2], bp[2 * s2], acc, 0, 0, 0);
          const int j = 32 * tj + (lane & 31), jr = 63 - j; const float g0j = gcs[j], g1j = gcs[64 + jr];
          bf16_t* AT0 = (bf16_t*)(rec0 + CL_AT); bf16_t* AT1 = (bf16_t*)(rec1 + CL_AT);
#pragma unroll
          for (int r = 0; r < 16; ++r) { const int i = 32 * ti + crow(r, h), ir = 63 - i;
              const float d0 = __expf(fminf(gcs[i] - g0j, 0.f)), d1 = __expf(fminf(gcs[64 + ir] - g1j, 0.f));
              if (pr == 0) { if (i > j) Lm0[j * 68 + i] = bes[i] * acc[r] * d0; else if (i < j) Lm1[jr * 68 + ir] = bes[64 + ir] * acc[r] * d1; }
              else { STG(bf16_t, AT0 + frag64(i, j)) = to_bf16(i >= j ? acc[r] * d0 : 0.f); STG(bf16_t, AT1 + frag64(ir, jr)) = to_bf16(i <= j ? acc[r] * d1 : 0.f); } }
#pragma unroll 1
          for (int d = 0; d < 2; ++d) { unsigned* QG = (unsigned*)((d ? rec1 : rec0) + CL_QG); unsigned* KD = (unsigned*)((d ? rec1 : rec0) + CL_KD); const float gl = gcs[d * 64 + 63];
              for (int e = t; e < 4096; e += 512) { const int il = e >> 6, d2 = (e & 63) * 2, io = d ? 63 - il : il; const float f = egs[d * 64 + il]; STG(unsigned, QG + (frag128(il, d2) >> 1)) = cvt_pk_bf16(Qs[io * 129 + d2] * f, Qs[io * 129 + d2 + 1] * f); }
              for (int e = t; e < 4096; e += 512) { const int dd = e >> 5, i2 = (e & 31) * 2, ia = d ? 63 - i2 : i2, ib = d ? 62 - i2 : i2 + 1;
                  STG(unsigned, KD + (frag64(dd, i2) >> 1)) = cvt_pk_bf16(Ks[ia * 129 + dd] * __expf(gl - gcs[d * 64 + i2]), Ks[ib * 129 + dd] * __expf(gl - gcs[d * 64 + i2 + 1])); } } }
        __syncthreads();
        {
            const int d = t >> 8, c = t & 255; int zoff; asm volatile("v_mov_b32 %0, 0" : "=v"(zoff));
            const float* LmT = (d ? Lm1 : Lm0) + zoff; const float* be = bes + d * 64 + zoff; const float* eg = egs + d * 64 + zoff;
            const float* src = c < 128 ? Vs + c : Ks + (c - 128); const int rs = d ? -129 : 129; src += d ? 63 * 129 : 0;
            f32x2 xv[32];
#pragma unroll
            for (int i = 0; i < 64; ++i) { const float v = src[i * rs] * be[i] * (c < 128 ? 1.0f : eg[i]); if (i & 1) xv[i >> 1].y = v; else xv[i >> 1].x = v; }
#pragma unroll
            for (int j = 0; j < 63; ++j) { const float xj = (j & 1) ? xv[j >> 1].y : xv[j >> 1].x; const int lj = __float_as_int(LmT[j * 68 + lane]);
#pragma unroll
                for (int i2 = (j + 1) / 2; i2 < 32; ++i2) {
                    if (2 * i2 > j) { f32x2 l; l.x = __int_as_float(__builtin_amdgcn_readlane(lj, 2 * i2)); l.y = __int_as_float(__builtin_amdgcn_readlane(lj, 2 * i2 + 1)); xv[i2] -= l * xj; }
                    else xv[i2].y -= __int_as_float(__builtin_amdgcn_readlane(lj, 2 * i2 + 1)) * xj; } }
            unsigned char* rec = d ? rec1 : rec0;
            if (c < 128) {
#pragma unroll
                for (int rt2 = 0; rt2 < 2; ++rt2)
#pragma unroll
                    for (int h2 = 0; h2 < 2; ++h2) { u32x4* dq = (u32x4*)(rec + CL_U) + (((c >> 5) * 2 + rt2) * 2) * 64 + h2 * 32 + (c & 31);
#pragma unroll
                        for (int half = 0; half < 2; ++half) { u32x4 w;
#pragma unroll
                            for (int dd = 0; dd < 4; ++dd) { const int g = 2 * half + (dd >> 1), ii = 32 * rt2 + 8 * g + 4 * h2 + 2 * (dd & 1); w[dd] = cvt_pk_bf16(xv[ii >> 1].x, xv[ii >> 1].y); }
                            STG(u32x4, dq + half * 64) = w; } } }
            else { bf16_t* dst = (bf16_t*)(rec + CL_WN); const int dk = c - 128;
#pragma unroll
                for (int i = 0; i < 32; ++i) { STG(bf16_t, dst + frag128(2 * i, dk)) = to_bf16(-xv[i].x); STG(bf16_t, dst + frag128(2 * i + 1, dk)) = to_bf16(-xv[i].y); } }
        }
    }
}
struct ScanTask { int b, head, dir, slice, cp0, nch, row0, L, samp; };
DI ScanTask scan_decode(int task) { ScanTask q;
    if (task < 128) { const int sc = task >> 2; q.slice = task & 3; q.b = sc >> 4; q.head = (sc >> 1) & 7; q.dir = sc & 1; q.cp0 = 64 + q.b * 32; q.nch = 32; q.row0 = 4096 + q.b * 2048; q.L = 2048; q.samp = 1; }
    else { const int pid = task - 128, pc = pid >> 2; q.slice = pid & 3; q.b = pc >> 4; q.head = (pc >> 1) & 7; q.dir = pc & 1; q.cp0 = q.b * 4; q.nch = 4; q.row0 = q.b * 256; q.L = 256; q.samp = 0; }
    return q; }
DI int scan_task_of(int G, int bid, int k) { return G == 256 ? (bid < 128 ? (k == 0 ? bid : 128 + 896 + bid) : 128 + (bid - 128) + 128 * k) : bid + k * G; }
DI void phase_dn_scan(const Params& p, unsigned char* smem, int slot) {
    bf16_t* St = (bf16_t*)smem;
    bf16_t* Vn = St + 32 * 136;
    const float* GL = (const float*)(p.ws + OFF_GL);
    float* ODIR = (float*)(p.ws + OFF_R1);
    const int t = opq_tid(), lane = t & 63, wave = __builtin_amdgcn_readfirstlane(t >> 6), h = lane >> 5, l31 = lane & 31;
    const int G = opq_gdim(), bid = opq_bid();
    const int ntask = (G == 256) ? (bid < 128 ? 2 : 7) : ((1152 - bid + G - 1) / G);
    u32x4 R0[12], R1[12]; float gl0, gl1;
    for (int k = 0; k < ntask; ++k) {
        const ScanTask tk = scan_decode(scan_task_of(G, bid, k)); const bool has_next = k + 1 < ntask; const ScanTask tn = scan_decode(scan_task_of(G, bid, has_next ? k + 1 : k));
        const int b = tk.b, head = tk.head, dir = tk.dir, slice = tk.slice, cp0 = tk.cp0, nch = tk.nch, row0 = tk.row0, L = tk.L; const bool samp = tk.samp != 0;
        f32x16 sacc; for (int i = 0; i < 16; ++i) sacc[i] = 0.f;
        const int rt = wave & 1, dkt = wave & 3;
        const unsigned char* rbase = p.ws + OFF_R2 + (size_t)((cp0 * 8 + head) * 2 + dir) * CL_STRIDE;
        const unsigned char* nrbase = p.ws + OFF_R2 + (size_t)((tn.cp0 * 8 + tn.head) * 2 + tn.dir) * CL_STRIDE;
        const unsigned aoffs = (unsigned)(wave < 2 ? CL_WN : CL_QG) + (unsigned)(((wave < 4 ? rt : 0) * 8) * 64 + lane) * 16u;
        const unsigned boffs = wave < 2 ? (unsigned)CL_U + (unsigned)(((slice * 2 + rt) * 2) * 64 + lane) * 16u
                             : (wave < 4 ? (unsigned)CL_AT + (unsigned)((rt * 4) * 64 + lane) * 16u : (unsigned)CL_KD + (unsigned)((dkt * 4) * 64 + lane) * 16u);
        const unsigned nboffs = wave < 2 ? (unsigned)CL_U + (unsigned)(((tn.slice * 2 + rt) * 2) * 64 + lane) * 16u
                             : (wave < 4 ? (unsigned)CL_AT + (unsigned)((rt * 4) * 64 + lane) * 16u : (unsigned)CL_KD + (unsigned)((dkt * 4) * 64 + lane) * 16u);
#define SCAN_SRC(cidx, off, noff) ((cidx) < nch ? rbase + (size_t)(cidx) * 16 * CL_STRIDE + (off) : (has_next ? nrbase + (size_t)((cidx) - nch) * 16 * CL_STRIDE + (noff) : rbase + (size_t)(nch - 1) * 16 * CL_STRIDE + (off)))
#define SCAN_ISSUE_A(R, cidx) do { const unsigned char* a_ = SCAN_SRC(cidx, aoffs, aoffs); const unsigned char* a2_ = a_ + 4096; \
            gld16<0>(R[0], a_); gld16<1024>(R[1], a_); gld16<2048>(R[2], a_); gld16<3072>(R[3], a_); gld16<0>(R[4], a2_); gld16<1024>(R[5], a2_); gld16<2048>(R[6], a2_); gld16<3072>(R[7], a2_); } while (0)
#define SCAN_ISSUE_B(R, gl, cidx) do { const unsigned char* b_ = SCAN_SRC(cidx, boffs, nboffs); \
            const int gi_ = (cidx) < nch ? ((cp0 + (cidx)) * 8 + head) * 2 + dir : (has_next ? ((tn.cp0 + (cidx) - nch) * 8 + tn.head) * 2 + tn.dir : ((cp0 + nch - 1) * 8 + head) * 2 + dir); \
            gld16<0>(R[8], b_); gld16<1024>(R[9], b_); gld16<2048>(R[10], b_); gld16<3072>(R[11], b_); gld4(gl, GL + gi_); } while (0)
#define SCAN_WAIT(N, R, gl) asm volatile("s_waitcnt vmcnt(" #N ")" : "+v"(R[0]), "+v"(R[1]), "+v"(R[2]), "+v"(R[3]), "+v"(R[4]), "+v"(R[5]), "+v"(R[6]), "+v"(R[7]), "+v"(R[8]), "+v"(R[9]), "+v"(R[10]), "+v"(R[11]), "+v"(gl) :: "memory")
#define SCAN_STEP(c, R, gl) do { \
            SCAN_WAIT(13, R, gl); \
            f32x16 acc; \
            if (wave < 4) { \
                if (wave < 2) { _Pragma("unroll") for (int j = 0; j < 4; ++j) { acc[2 * j] = __uint_as_float(R[8][j] << 16); acc[2 * j + 1] = __uint_as_float(R[8][j] & 0xffff0000u); acc[8 + 2 * j] = __uint_as_float(R[9][j] << 16); acc[8 + 2 * j + 1] = __uint_as_float(R[9][j] & 0xffff0000u); } } \
                else { _Pragma("unroll") for (int r = 0; r < 16; ++r) acc[r] = 0.f; } \
                _Pragma("unroll") for (int ks = 0; ks < 8; ++ks) { const bf16x8 bb = *(const bf16x8*)(St + l31 * 136 + ks * 16 + 8 * h); \
                    acc = __builtin_amdgcn_mfma_f32_32x32x16_bf16(__builtin_bit_cast(bf16x8, R[ks]), bb, acc, 0, 0, 0); } \
                if (wave < 2) { _Pragma("unroll") for (int gq = 0; gq < 4; ++gq) { u32x2 w; w.x = cvt_pk_bf16(acc[4 * gq], acc[4 * gq + 1]); w.y = cvt_pk_bf16(acc[4 * gq + 2], acc[4 * gq + 3]); \
                        *(u32x2*)(Vn + l31 * 72 + 32 * rt + 8 * gq + 4 * h) = w; } } \
            } \
            asm volatile("s_nop 7\n\ts_nop 7" ::: "memory"); \
            SCAN_ISSUE_A(R, (c) + 2); \
            LDSBAR(); \
            if (wave == 2 || wave == 3) { \
                _Pragma("unroll") for (int ks = 0; ks < 4; ++ks) { const bf16x8 bb = *(const bf16x8*)(Vn + l31 * 72 + ks * 16 + 8 * h); \
                    acc = __builtin_amdgcn_mfma_f32_32x32x16_bf16(__builtin_bit_cast(bf16x8, R[8 + ks]), bb, acc, 0, 0, 0); } \
                const unsigned voff = (unsigned)l31 + (unsigned)(dir ? 1 - h : h) * 4096u; \
                float* ob = ODIR + (size_t)dir * 8388608 + head * 128 + slice * 32 + (size_t)(row0 - (dir ? 4 : 0)) * 1024; \
                _Pragma("unroll") for (int r = 0; r < 16; ++r) { const int iu = 32 * rt + (r & 3) + 8 * (r >> 2); const int pu = dir ? L - 1 - (64 * (c) + iu) : 64 * (c) + iu; STG(float, ob + (size_t)pu * 1024 + voff) = acc[r]; } \
            } else if (wave >= 4) { \
                _Pragma("unroll") for (int r = 0; r < 16; ++r) sacc[r] *= gl; \
                _Pragma("unroll") for (int ks = 0; ks < 4; ++ks) { const bf16x8 bb = *(const bf16x8*)(Vn + l31 * 72 + ks * 16 + 8 * h); \
                    sacc = __builtin_amdgcn_mfma_f32_32x32x16_bf16(__builtin_bit_cast(bf16x8, R[8 + ks]), bb, sacc, 0, 0, 0); } \
                _Pragma("unroll") for (int gq = 0; gq < 4; ++gq) { u32x2 w; w.x = cvt_pk_bf16(sacc[4 * gq], sacc[4 * gq + 1]); w.y = cvt_pk_bf16(sacc[4 * gq + 2], sacc[4 * gq + 3]); \
                    *(u32x2*)(St + l31 * 136 + 32 * dkt + 8 * gq + 4 * h) = w; } \
            } \
            asm volatile("s_nop 7\n\ts_nop 7" ::: "memory"); \
            SCAN_ISSUE_B(R, gl, (c) + 2); \
            LDSBAR(); } while (0)
        __syncthreads();
        if (wave >= 4) {
            if (samp) { const float* s0 = p.state_a + ((((size_t)b * 2 + slot) * 2 + dir) * 8 + head) * 16384;
#pragma unroll
                for (int r = 0; r < 16; ++r) sacc[r] = LDG(float, s0 + (32 * dkt + crow(r, h)) * 128 + slice * 32 + l31); }
#pragma unroll
            for (int gq = 0; gq < 4; ++gq) { u32x2 w; w.x = cvt_pk_bf16(sacc[4 * gq], sacc[4 * gq + 1]); w.y = cvt_pk_bf16(sacc[4 * gq + 2], sacc[4 * gq + 3]);
                *(u32x2*)(St + l31 * 136 + 32 * dkt + 8 * gq + 4 * h) = w; } }
        __syncthreads();
        if (k == 0) { SCAN_ISSUE_A(R0, 0); SCAN_ISSUE_B(R0, gl0, 0); SCAN_ISSUE_A(R1, 1); SCAN_ISSUE_B(R1, gl1, 1); }
        for (int c = 0; c < nch; c += 2) { SCAN_STEP(c, R0, gl0); SCAN_STEP(c + 1, R1, gl1); }
        if (!samp && wave >= 4) { float* so = p.out + 8388608 + ((((size_t)b * 2 + slot) * 2 + dir) * 8 + head) * 16384;
#pragma unroll
            for (int r = 0; r < 16; ++r) STG(float, so + (32 * dkt + crow(r, h)) * 128 + slice * 32 + l31) = sacc[r]; }
        SCAN_WAIT(0, R0, gl0); SCAN_WAIT(0, R1, gl1);
#undef SCAN_SRC
#undef SCAN_ISSUE_A
#undef SCAN_ISSUE_B
#undef SCAN_WAIT
#undef SCAN_STEP
    }
}
DI void phase_dn_post(const Params& p, int slot) {
    const int lane = opq_tid() & 63, gw = opq_bid() * 8 + (opq_tid() >> 6), NGW = opq_gdim() * 8;
    const float* ODIR = (const float*)(p.ws + OFF_R1); const bf16_t* ZS = (const bf16_t*)(p.ws + OFF_ZS); bf16_t* H = (bf16_t*)(p.ws + OFF_H);
    const f32x2 g = *(const f32x2*)(p.a_norm_g + slot * 128 + lane * 2);
    for (int task = gw; task < 8192 * 8; task += NGW) {
        const size_t off = (size_t)(task >> 3) * 1024 + (task & 7) * 128 + lane * 2;
        const f32x2 a = *(const f32x2*)(ODIR + off), b = *(const f32x2*)(ODIR + 8388608 + off); const float o0 = a.x + b.x, o1 = a.y + b.y;
        const float rstd = rsqrtf(wave_sum(o0 * o0 + o1 * o1) * (1.0f / 128.f) + EPSF);
        const unsigned z = *(const unsigned*)(ZS + off);
        *(unsigned*)(H + off) = cvt_pk_bf16(o0 * rstd * g.x * __uint_as_float(z << 16), o1 * rstd * g.y * __uint_as_float(z & 0xffff0000u));
    }
}

DI void phase_at_prep(const Params& p, unsigned char* smem) {
    const int t = opq_tid(), lane = t & 63, gw = opq_bid() * 8 + (t >> 6), NGW = opq_gdim() * 8;
    const float* QKV = (const float*)(p.ws + OFF_R1); unsigned char* R2 = p.ws + OFF_R2;
    bf16_t* QB = (bf16_t*)(R2 + A_QB); bf16_t* KS = (bf16_t*)(R2 + A_KS); bf16_t* KP = (bf16_t*)(R2 + A_KP); bf16_t* VTS = (bf16_t*)(R2 + A_VTS); bf16_t* VTP = (bf16_t*)(R2 + A_VTP);
    float* ock = p.out + 16777216; float* ocv = p.out + 20971520;
    { const int st = lane >> 4, li = lane & 15, gq = li >> 2, cc = gq >> 1, half = gq & 1, f0 = 4 * (li & 3), d1 = cc * 64 + half * 32 + f0, d2 = d1 + 16;
      float invf[4];
#pragma unroll
      for (int k = 0; k < 4; ++k) invf[k] = exp2f(-(float)(f0 + k) * 0.8304820237218407f);
      for (int wt = gw; wt < 32768; wt += NGW) {
        const int T = wt * 4 + st, r = T >> 4, hq = T & 15, which = hq >> 3, head = hq & 7;
        const float* src = QKV + (size_t)r * 3072 + which * 1024 + head * 128;
        f32x4 x1 = LDG(f32x4, src + d1), x2 = LDG(f32x4, src + d2);
        bf16_t* dst;
        if (r >= 4096) { const int q = r - 4096, b = q >> 11, tk = q & 2047; const float pos = (float)(half ? (tk & 63) : (tk >> 6));
#pragma unroll
            for (int k = 0; k < 4; ++k) { const float ang = pos * invf[k]; const float n = rintf(ang * 0.15915494309189535f); float rr = fmaf(-n, 6.28125f, ang); rr = fmaf(-n, 1.9353071795864769e-3f, rr);
                const float sn = __sinf(rr), cs = __cosf(rr); const float o1 = x1[k] * cs - x2[k] * sn, o2 = x2[k] * cs + x1[k] * sn; x1[k] = o1; x2[k] = o2; }
            dst = which ? KS + ((size_t)(b * 8 + head) * 2304 + tk) * 128 : QB + (size_t)r * 1024 + head * 128;
        } else { const int b = r >> 8, tk = r & 255;
            dst = which ? KP + ((size_t)(b * 8 + head) * 256 + tk) * 128 : QB + (size_t)r * 1024 + head * 128;
            if (which) { float* o = ock + ((size_t)r * 8 + head) * 128; STG(f32x4, o + d1) = x1; STG(f32x4, o + d2) = x2; } }
        u32x2 w1, w2; w1.x = cvt_pk_bf16(x1[0], x1[1]); w1.y = cvt_pk_bf16(x1[2], x1[3]); w2.x = cvt_pk_bf16(x2[0], x2[1]); w2.y = cvt_pk_bf16(x2[2], x2[3]);
        STG(u32x2, dst + d1) = w1; STG(u32x2, dst + d2) = w2;
      } }
    for (int task = gw; task < 4096; task += NGW) { const int head = task & 7, pp = (task >> 3) & 255, b = task >> 11;
        const f32x2 v = *(const f32x2*)(p.cache_k + ((size_t)(b * 256 + pp) * 8 + head) * 128 + lane * 2);
        *(unsigned*)(KS + ((size_t)(b * 8 + head) * 2304 + 2048 + pp) * 128 + lane * 2) = cvt_pk_bf16(v.x, v.y); }
    float* Ts = (float*)smem;
    for (int task = opq_bid(); task < 1088; task += opq_gdim()) {
        __syncthreads();
        const int i = t >> 3, sg = (t & 7) * 16;
        int b, head, tile, nk; bf16_t* dstb; const float* srow; float* orow = nullptr;
        if (task < 576) { b = task / 288; const int rem = task % 288; head = rem / 36; tile = rem % 36; nk = 2304; dstb = VTS + (size_t)(b * 8 + head) * 128 * 2304;
            if (tile < 32) srow = QKV + (size_t)(4096 + b * 2048 + tile * 64 + i) * 3072 + 2048 + head * 128; else srow = p.cache_v + ((size_t)(b * 256 + (tile - 32) * 64 + i) * 8 + head) * 128; }
        else { const int q = task - 576; b = q >> 5; head = (q >> 2) & 7; tile = q & 3; nk = 256; dstb = VTP + (size_t)(b * 8 + head) * 128 * 256;
            srow = QKV + (size_t)(b * 256 + tile * 64 + i) * 3072 + 2048 + head * 128; orow = ocv + ((size_t)(b * 256 + tile * 64 + i) * 8 + head) * 128; }
#pragma unroll
        for (int q = 0; q < 4; ++q) { const f32x4 a = LDG(f32x4, srow + sg + q * 4); if (orow) STG(f32x4, orow + sg + q * 4) = a;
#pragma unroll
            for (int j = 0; j < 4; ++j) Ts[i * 129 + sg + q * 4 + j] = a[j]; }
        __syncthreads();
        { const int e = t >> 2, ck = (t & 3) * 16; u32x4 w0, w1; const float* s = Ts + ck * 129 + e;
          w0.x = cvt_pk_bf16(s[0], s[129]); w0.y = cvt_pk_bf16(s[2 * 129], s[3 * 129]); w0.z = cvt_pk_bf16(s[4 * 129], s[5 * 129]); w0.w = cvt_pk_bf16(s[6 * 129], s[7 * 129]);
          w1.x = cvt_pk_bf16(s[8 * 129], s[9 * 129]); w1.y = cvt_pk_bf16(s[10 * 129], s[11 * 129]); w1.z = cvt_pk_bf16(s[12 * 129], s[13 * 129]); w1.w = cvt_pk_bf16(s[14 * 129], s[15 * 129]);
          bf16_t* d = dstb + (size_t)e * nk + tile * 64 + ck; STG(u32x4, d) = w0; STG(u32x4, d + 8) = w1; }
    }
}
DI void phase_attn(const Params& p, unsigned char* smem, float lam_init) {
    const int t = opq_tid(), lane = t & 63, wave = __builtin_amdgcn_readfirstlane(t >> 6), h = lane >> 5, l31 = lane & 31, cc = wave >> 2, rq = wave & 3;
    unsigned char* R2 = p.ws + OFF_R2;
    const bf16_t* QB = (const bf16_t*)(R2 + A_QB); const bf16_t* KS = (const bf16_t*)(R2 + A_KS); const bf16_t* KP = (const bf16_t*)(R2 + A_KP);
    const bf16_t* VTS = (const bf16_t*)(R2 + A_VTS); const bf16_t* VTP = (const bf16_t*)(R2 + A_VTP); bf16_t* H = (bf16_t*)(p.ws + OFF_H);
    bf16_t* Kt = (bf16_t*)smem;
    bf16_t* Vt = Kt + 2 * 64 * 136;
    float* OX = (float*)smem;
    float d01 = 0.f, d23 = 0.f;
    for (int i = 0; i < 64; ++i) { d01 += p.b_lam[i] * p.b_lam[64 + i]; d23 += p.b_lam[128 + i] * p.b_lam[192 + i]; }
    const float lam = expf(d01) - expf(d23) + lam_init;
    const float sc2 = 0.125f * 1.4426950408889634f;
    for (int item = opq_bid(); item < 512; item += opq_gdim()) {
        int b, head, qrow0, nk; const bf16_t *Kb, *Vb;
        if (item < 256) { b = item >> 7; head = (item >> 4) & 7; qrow0 = 4096 + b * 2048 + (item & 15) * 128; nk = 2304; Kb = KS + (size_t)(b * 8 + head) * 2304 * 128; Vb = VTS + (size_t)(b * 8 + head) * 128 * 2304; }
        else { const int j = item - 256; b = j >> 4; head = (j >> 1) & 7; qrow0 = b * 256 + (j & 1) * 128; nk = 256; Kb = KP + (size_t)(b * 8 + head) * 256 * 128; Vb = VTP + (size_t)(b * 8 + head) * 128 * 256; }
        const int nkt = nk / 64, qrow = qrow0 + rq * 32 + l31;
        bf16x8 bq[4];
#pragma unroll
        for (int ks = 0; ks < 4; ++ks) bq[ks] = LDG(bf16x8, QB + (size_t)qrow * 1024 + head * 128 + cc * 64 + ks * 16 + 8 * h);
        f32x16 ao[4];
#pragma unroll
        for (int et = 0; et < 4; ++et) for (int i = 0; i < 16; ++i) ao[et][i] = 0.f;
        float mrun = -1e30f, lrun = 0.f;
        const int kkey = t >> 3, kch = t & 7;
        u32x4 kr[2], vr[2];
#pragma unroll
        for (int u = 0; u < 2; ++u) { const int id = t + u * 512, key = id >> 4, ch = id & 15; kr[u] = LDG(u32x4, Kb + (size_t)key * 128 + ch * 8);
            const int e = id >> 3, c8 = id & 7; vr[u] = LDG(u32x4, Vb + (size_t)e * nk + c8 * 8); }
        __syncthreads();
#pragma unroll
        for (int u = 0; u < 2; ++u) { const int id = t + u * 512, key = id >> 4, ch = id & 15; *(u32x4*)(Kt + key * 136 + ch * 8) = kr[u];
            const int e = id >> 3, c8 = id & 7; *(u32x4*)(Vt + e * 72 + c8 * 8) = vr[u]; }
        (void)kkey; (void)kch;
        for (int kt = 0; kt < nkt; ++kt) {
            LDSBAR();
            const int buf = kt & 1; const bool more = kt + 1 < nkt;
            if (more) {
#pragma unroll
                for (int u = 0; u < 2; ++u) { const int id = t + u * 512, key = id >> 4, ch = id & 15; kr[u] = LDG(u32x4, Kb + (size_t)((kt + 1) * 64 + key) * 128 + ch * 8);
                    const int e = id >> 3, c8 = id & 7; vr[u] = LDG(u32x4, Vb + (size_t)e * nk + (kt + 1) * 64 + c8 * 8); } }
            const bf16_t* Kc = Kt + buf * 64 * 136; const bf16_t* Vc = Vt + buf * 128 * 72;
            f32x16 as[2];
#pragma unroll
            for (int sub = 0; sub < 2; ++sub) { for (int i = 0; i < 16; ++i) as[sub][i] = 0.f;
#pragma unroll
                for (int ks = 0; ks < 4; ++ks) { const bf16x8 a = *(const bf16x8*)(Kc + (32 * sub + l31) * 136 + cc * 64 + ks * 16 + 8 * h);
                    as[sub] = __builtin_amdgcn_mfma_f32_32x32x16_bf16(a, bq[ks], as[sub], 0, 0, 0); } }
            float mx = -1e30f;
#pragma unroll
            for (int sub = 0; sub < 2; ++sub)
#pragma unroll
                for (int i = 0; i < 16; ++i) mx = fmaxf(mx, as[sub][i]);
            mx = fmaxf(mx, shfl_lane(mx, lane ^ 32)) * sc2;
            const float mnew = fmaxf(mrun, mx), alpha = __builtin_amdgcn_exp2f(mrun - mnew); mrun = mnew;
            float ls = 0.f;
#pragma unroll
            for (int sub = 0; sub < 2; ++sub)
#pragma unroll
                for (int i = 0; i < 16; ++i) { const float pv = __builtin_amdgcn_exp2f(as[sub][i] * sc2 - mnew); as[sub][i] = pv; ls += pv; }
            lrun = lrun * alpha + ls;
#pragma unroll
            for (int et = 0; et < 4; ++et)
#pragma unroll
                for (int i = 0; i < 16; ++i) ao[et][i] *= alpha;
            bf16x8 pf[2][2];
#pragma unroll
            for (int sub = 0; sub < 2; ++sub)
#pragma unroll
                for (int s = 0; s < 2; ++s) { u32x4 w; w.x = cvt_pk_bf16(as[sub][8 * s], as[sub][8 * s + 1]); w.y = cvt_pk_bf16(as[sub][8 * s + 2], as[sub][8 * s + 3]);
                    w.z = cvt_pk_bf16(as[sub][8 * s + 4], as[sub][8 * s + 5]); w.w = cvt_pk_bf16(as[sub][8 * s + 6], as[sub][8 * s + 7]); pf[sub][s] = __builtin_bit_cast(bf16x8, w); }
#pragma unroll
            for (int et = 0; et < 4; ++et)
#pragma unroll
                for (int sub = 0; sub < 2; ++sub)
#pragma unroll
                    for (int s = 0; s < 2; ++s) { const bf16_t* vp = Vc + (32 * et + l31) * 72 + 32 * sub + 16 * s + 4 * h;
                        const s16x4 lo = *(const s16x4*)vp, hi = *(const s16x4*)(vp + 8);
                        const bf16x8 a = __builtin_shufflevector(lo, hi, 0, 1, 2, 3, 4, 5, 6, 7);
                        ao[et] = __builtin_amdgcn_mfma_f32_32x32x16_bf16(a, pf[sub][s], ao[et], 0, 0, 0); }
            if (more) {
                bf16_t* Kn = Kt + (buf ^ 1) * 64 * 136; bf16_t* Vnx = Vt + (buf ^ 1) * 128 * 72;
#pragma unroll
                for (int u = 0; u < 2; ++u) { const int id = t + u * 512, key = id >> 4, ch = id & 15; *(u32x4*)(Kn + key * 136 + ch * 8) = kr[u];
                    const int e = id >> 3, c8 = id & 7; *(u32x4*)(Vnx + e * 72 + c8 * 8) = vr[u]; } }
        }
        const float ltot = lrun + shfl_lane(lrun, lane ^ 32); const float inv = 1.0f / ltot;
        __syncthreads();
        if (cc == 1) { const float f = -lam * inv;
#pragma unroll
            for (int et = 0; et < 4; ++et)
#pragma unroll
                for (int i = 0; i < 16; ++i) OX[((rq * 4 + et) * 16 + i) * 64 + lane] = ao[et][i] * f; }
        __syncthreads();
        if (cc == 0) { float ss = 0.f;
#pragma unroll
            for (int et = 0; et < 4; ++et)
#pragma unroll
                for (int i = 0; i < 16; ++i) { const float o = ao[et][i] * inv + OX[((rq * 4 + et) * 16 + i) * 64 + lane]; ao[et][i] = o; ss += o * o; }
            ss += shfl_lane(ss, lane ^ 32);
            const float rstd = rsqrtf(ss * (1.0f / 128.f) + EPSF) * (1.0f - lam_init);
            bf16_t* op = H + (size_t)qrow * 1024 + head * 128;
#pragma unroll
            for (int et = 0; et < 4; ++et)
#pragma unroll
                for (int gq = 0; gq < 4; ++gq) { const int e0 = 32 * et + 8 * gq + 4 * h; const f32x4 g = LDG(f32x4, p.b_norm_g + e0);
                    u32x2 w; w.x = cvt_pk_bf16(ao[et][4 * gq] * rstd * g.x, ao[et][4 * gq + 1] * rstd * g.y); w.y = cvt_pk_bf16(ao[et][4 * gq + 2] * rstd * g.z, ao[et][4 * gq + 3] * rstd * g.w);
                    STG(u32x2, op + e0) = w; } }
    }
}

DI void phase_pool(const Params& p) {
    const float* HF = (const float*)(p.ws + OFF_HF); bf16_t* H = (bf16_t*)(p.ws + OFF_H);
    for (int i = opq_bid() * 512 + opq_tid(); i < 8192 * 256; i += opq_gdim() * 512) {
        const int r = i >> 8, c4 = (i & 255) * 4, gI = c4 >> 8, hw = 1 << gI;
        int row0, pos, L; seq_of_row(r, row0, pos, L);
        const int lo = max(pos - hw, 0), hi = min(pos + hw, L);
        f32x4 s = {0, 0, 0, 0};
        for (int q = lo; q < hi; ++q) s += *(const f32x4*)(HF + (size_t)(row0 + q) * 1024 + c4);
        const f32x4 me = *(const f32x4*)(HF + (size_t)r * 1024 + c4);
        const float ic = 1.0f / (float)(hi - lo); s = s * ic - me;
        u32x2 w; w.x = cvt_pk_bf16(s.x, s.y); w.y = cvt_pk_bf16(s.z, s.w); *(u32x2*)(H + (size_t)r * 1024 + c4) = w;
    }
}


#define XB_TMO      128
#define XB_XCNT(j)  (256  + 64 * (j))
#define XB_XSUB(j)  (1280 + 64 * (j))
#define XB_XGEN(j)  (2304 + 64 * (j))
#define XB_TOP      3328
#define XB_TOPGEN   3392
#define XCD_BAR_WORDS 3456
#define XB_SPIN_CAP (1u << 20)
DI unsigned xb_ld(unsigned* p)              { return __hip_atomic_load(p, __ATOMIC_RELAXED, __HIP_MEMORY_SCOPE_AGENT); }
DI unsigned xb_add(unsigned* p, unsigned v) { return __hip_atomic_fetch_add(p, v, __ATOMIC_RELAXED, __HIP_MEMORY_SCOPE_AGENT); }
DI unsigned xb_xcc_id() { return (unsigned)__builtin_amdgcn_s_getreg((3 << 11) | 20) & 0xFu; }
#define XB_SPIN(cond, bar) do { unsigned _sp = 0; while (cond) { __builtin_amdgcn_s_sleep(1); \
    if ((++_sp & 255u) == 0u) { if (xb_ld(&(bar)[XB_TMO])) break; if (_sp > XB_SPIN_CAP) { atomicAdd(&(bar)[XB_TMO], 1u); break; } } } } while (0)
DI void xcd_barrier_complete(unsigned* bar, unsigned x, unsigned& nloc, unsigned& nx) {
    const unsigned G = gridDim.x;
    unsigned sum, cnt, mine, sp = 0u;
    for (;;) {
        sum = 0u; cnt = 0u; mine = 0u;
#pragma unroll
        for (unsigned j = 0; j < 16; ++j) { const unsigned c = xb_ld(&bar[XB_XCNT(j)]); sum += c; cnt += (c > 0u) ? 1u : 0u; mine = (j == x) ? c : mine; }
        if (sum == G) break;
        __builtin_amdgcn_s_sleep(1);
        if ((++sp & 255u) == 0u) { if (xb_ld(&bar[XB_TMO])) break; if (sp > XB_SPIN_CAP) { atomicAdd(&bar[XB_TMO], 1u); break; } }
    }
    nloc = mine > 0u ? mine : 1u; nx = cnt > 0u ? cnt : 1u;
}
DI void xcd_barrier(unsigned* bar, volatile LAS unsigned* st) {
    asm volatile("s_waitcnt vmcnt(0)" ::: "memory");
    __syncthreads();
    if (threadIdx.x == 0) {
        const unsigned x = xb_xcc_id();
        __builtin_amdgcn_s_waitcnt(0);
        unsigned nloc = st[0], nx = st[1];
        if (nloc == 0u) { xcd_barrier_complete(bar, x, nloc, nx); st[0] = nloc; st[1] = nx; }
        const unsigned old = xb_add(&bar[XB_XSUB(x)], 1u);
        const unsigned gen = old / nloc;
        if (old + 1u == (gen + 1u) * nloc) {
            __builtin_amdgcn_fence(__ATOMIC_RELEASE, "agent");
            asm volatile("s_waitcnt vmcnt(0)" ::: "memory");
            const unsigned og = xb_add(&bar[XB_TOP], 1u);
            const unsigned tg = og / nx;
            if (og + 1u == (tg + 1u) * nx) xb_add(&bar[XB_TOPGEN], 1u);
            else XB_SPIN(xb_ld(&bar[XB_TOPGEN]) == tg, bar);
            __builtin_amdgcn_fence(__ATOMIC_ACQUIRE, "agent");
            xb_add(&bar[XB_XGEN(x)], 1u);
            asm volatile("s_waitcnt vmcnt(0)" ::: "memory");
        } else {
            XB_SPIN(xb_ld(&bar[XB_XGEN(x)]) == gen, bar);
            __builtin_amdgcn_fence(__ATOMIC_ACQUIRE, "agent");
            asm volatile("s_waitcnt vmcnt(0)" ::: "memory");
        }
    }
    __syncthreads();
}

__shared__ Params s_params;
DI Params load_params() {
    Params q; const unsigned* src = (const unsigned*)&s_params; unsigned* dst = (unsigned*)&q;
#pragma unroll
    for (int i = 0; i < (int)(sizeof(Params) / 4); ++i) dst[i] = __builtin_amdgcn_readfirstlane(src[i]);
    return q;
}
__global__ void __launch_bounds__(512, 2) mega(Params pk) {
    extern __shared__ __attribute__((aligned(16))) unsigned char smem[];
    cg::grid_group grid = cg::this_grid();
    __shared__ uint4 xb_words;
    if (opq_tid() == 0) { s_params = pk; xb_words = make_uint4(0u, 0u, 0u, 0u); }
    if (blockIdx.x == 0) for (int i = threadIdx.x; i < XCD_BAR_WORDS; i += 512) ((unsigned*)(pk.ws + OFF_BAR))[i] = 0u;
    __syncthreads();
#define GSYNC() xcd_barrier((unsigned*)(load_params().ws + OFF_BAR), (volatile LAS unsigned*)&xb_words)
#define PHASE(ty, ...) do { { const Params p = load_params(); const float cfmul = 1.0f; (void)cfmul; __VA_ARGS__; } \
        if ((DUP_MASK >> (ty)) & 1) { GSYNC(); const Params p = load_params(); const float cfmul = 1.0f; (void)cfmul; __VA_ARGS__; } \
        if ((DUP_MASK >> 15) & 1) GSYNC(); \
        GSYNC(); } while (0)
#define WS_H ((bf16_t*)(p.ws + OFF_H))
#define WS_X ((float*)(p.ws + OFF_X))
#define WS_ACT ((bf16_t*)(p.ws + OFF_R2))
#define MODL ((const float*)(p.ws + OFF_MODS) + layer * 27648)
    { const Params p = load_params(); phase_convert(p, smem); phase_modpart(p, smem); if (DUP_MASK & 1) { phase_convert(p, smem); phase_modpart(p, smem); } }
    grid.sync();
    if (threadIdx.x == 0) (void)xb_add((unsigned*)(load_params().ws + OFF_BAR) + XB_XCNT(xb_xcc_id()), 1u);
    PHASE(1, phase_modreduce(p));
    for (int layer = 0; layer < 4; ++layer) {
        const int kind = layer % 3, slot = layer / 3;
        for (int sub = 0; sub < 3; ++sub) {
            const int j0 = sub * 3;
            const int nmode = (layer == 0 && sub == 0) ? 1 : ((sub == 1 && kind == 2) ? 2 : 0);
            const int nparts = (layer == 0 && sub == 0) ? 0 : ((sub == 2 && kind == 2) ? 1 : 2);
            PHASE(2, phase_norm(p, nmode, cfmul != 0.f ? nparts : 0, p.norm_g + (layer * 3 + sub) * 1024, MODL, j0, j0 + 1));
            if (sub != 1) {
                const int idx = layer * 2 + (sub >> 1);
                PHASE(3, { pg8::EpiSwiglu E; E.O = WS_ACT; run_gemm(smem, WS_H, 1024, (const bf16_t*)(p.ws + OFF_WGU + idx * SZ_WGU1), 1024, 22, 1, 1024, 0, E); convert_in_gemm_tail(p, smem, layer, sub >> 1); });
                PHASE(4, { pg8::EpiResid E; E.PB = (bf16_t*)(p.ws + OFF_R1); E.gate = MODL + (j0 + 2) * 1024; E.colscale = nullptr; E.cf = 0.5f * cfmul;
                        run_gemm(smem, WS_ACT, 2816, (const bf16_t*)(p.ws + OFF_WD + idx * SZ_WD1), 2816, 4, 2, 1408, 0, E); });
            } else if (kind == 0) {
                PHASE(5, { pg8::EpiF32 E; E.C = (float*)(p.ws + OFF_R1); E.ldc = 4096; run_gemm(smem, WS_H, 1024, (const bf16_t*)(p.ws + OFF_WIN + slot * SZ_WIN1), 1024, 16, 1, 1024, 0, E); phase_dn_gates(p, slot); });
                PHASE(7, phase_dn_chunk(p, smem, slot));
                PHASE(8, phase_dn_scan(p, smem, slot));
                PHASE(9, phase_dn_post(p, slot));
                PHASE(10, { pg8::EpiResid E; E.PB = (bf16_t*)(p.ws + OFF_R1); E.gate = MODL + 5 * 1024; E.colscale = nullptr; E.cf = cfmul;
                        run_gemm(smem, WS_H, 1024, (const bf16_t*)(p.ws + OFF_WAO + slot * 2097152ull), 1024, 4, 2, 512, 0, E); });
            } else if (kind == 1) {
                PHASE(11, { pg8::EpiF32 E; E.C = (float*)(p.ws + OFF_R1); E.ldc = 3072; run_gemm(smem, WS_H, 1024, (const bf16_t*)(p.ws + OFF_WQKV), 1024, 12, 1, 1024, 0, E); convert_in_qkv_tail(p, smem); });
                PHASE(12, phase_at_prep(p, smem));
                PHASE(13, phase_attn(p, smem, 0.8f - 0.6f * 0.7408182206817179f));
                PHASE(10, { pg8::EpiResid E; E.PB = (bf16_t*)(p.ws + OFF_R1); E.gate = MODL + 5 * 1024; E.colscale = nullptr; E.cf = cfmul;
                        run_gemm(smem, WS_H, 1024, (const bf16_t*)(p.ws + OFF_WBO), 1024, 4, 2, 512, 0, E); });
            } else {
                PHASE(14, phase_pool(p));
                PHASE(10, { pg8::EpiResid E; E.PB = (bf16_t*)(p.ws + OFF_R1); E.gate = MODL + 5 * 1024; E.colscale = p.c_scale + slot * 1024; E.cf = cfmul;
                        run_gemm(smem, WS_H, 1024, (const bf16_t*)(p.ws + OFF_WPOOL), 256, 4, 1, 256, 256, E); });
            }
        }
    }
    { const Params p = load_params(); phase_norm(p, 3, 2, p.final_g, (const float*)(p.ws + OFF_MODS), 0, 0); }
#undef PHASE
}

extern "C" void kernel_launch(void* const* d_in, const int* in_sizes, int n_in, void* d_out, int out_size, void* d_ws, size_t ws_size, hipStream_t stream) {
    static int grid = 0;
    if (grid == 0) {
        if (n_in != 26 || ws_size < WS_END) { fprintf(stderr, "kernel_launch: unexpected n_in %d or workspace %zu < %zu\n", n_in, ws_size, (size_t)WS_END); grid = -1; return; }
        int dev = 0, cus = 0, per_cu = 0;
        hipGetDevice(&dev); hipDeviceGetAttribute(&cus, hipDeviceAttributeMultiprocessorCount, dev);
        if (hipFuncSetAttribute((const void*)mega, hipFuncAttributeMaxDynamicSharedMemorySize, LDS_BYTES) != hipSuccess) { fprintf(stderr, "kernel_launch: hipFuncSetAttribute failed\n"); grid = -1; return; }
        if (hipOccupancyMaxActiveBlocksPerMultiprocessor(&per_cu, (const void*)mega, 512, LDS_BYTES) != hipSuccess || per_cu < 1) { fprintf(stderr, "kernel_launch: occupancy query says %d\n", per_cu); per_cu = 1; }
        (void)hipGetLastError();
        grid = cus;
    }
    if (grid < 0) return;
    Params p; memset(&p, 0, sizeof(p));
    const float** f = (const float**)&p;
    for (int i = 0; i < 26; ++i) f[i] = (const float*)d_in[i];
    p.out = (float*)d_out; p.ws = (unsigned char*)d_ws; p.ph_begin = 0; p.ph_end = 1000;
    void* args[] = {&p};
    hipError_t e = hipLaunchCooperativeKernel((const void*)mega, dim3(grid), dim3(512), args, LDS_BYTES, stream);
    if (e != hipSuccess) fprintf(stderr, "cooperative launch failed: %s (grid %d)\n", hipGetErrorString(e), grid);
}
```

```cpp
#include <hip/hip_runtime.h>
#include <hip/hip_cooperative_groups.h>
#include <cstdio>
#include <cstring>
namespace cg = cooperative_groups;

#define LAS __attribute__((address_space(3)))
#define GAS __attribute__((address_space(1)))
#define LDG(T, ptr) (*(const GAS T*)(ptr))
#define STG(T, ptr) (*(GAS T*)(ptr))
#define DI __device__ __forceinline__
typedef unsigned short bf16_t;
typedef short bf16x8 __attribute__((ext_vector_type(8)));
typedef short s16x4 __attribute__((ext_vector_type(4)));
typedef float f32x2 __attribute__((ext_vector_type(2)));
typedef float f32x4 __attribute__((ext_vector_type(4)));
typedef float f32x16 __attribute__((ext_vector_type(16)));
typedef unsigned u32x2 __attribute__((ext_vector_type(2)));
typedef unsigned u32x4 __attribute__((ext_vector_type(4)));

constexpr size_t SZ_WGU1 = 5632ull * 1024 * 2;
constexpr size_t SZ_WD1 = 1024ull * 2816 * 2;
constexpr size_t SZ_WIN1 = 4128ull * 1024 * 2;
constexpr size_t OFF_WGU = 0;
constexpr size_t OFF_WD = OFF_WGU + 8 * SZ_WGU1;
constexpr size_t OFF_WIN = OFF_WD + 8 * SZ_WD1;
constexpr size_t OFF_WAO = OFF_WIN + 2 * SZ_WIN1;
constexpr size_t OFF_WQKV = OFF_WAO + 2 * 2097152ull;
constexpr size_t OFF_WBO = OFF_WQKV + 3072ull * 1024 * 2;
constexpr size_t OFF_WPOOL = OFF_WBO + 2097152ull;
constexpr size_t OFF_MODS = OFF_WPOOL + 1024ull * 256 * 2;
constexpr size_t OFF_X = OFF_MODS + 110592ull * 4;
constexpr size_t OFF_H = OFF_X + 8192ull * 1024 * 4;
constexpr size_t OFF_R1 = OFF_H + 8192ull * 1024 * 2;
constexpr size_t SZ_R1 = 134217728ull;
constexpr size_t OFF_HF = OFF_R1 + 67108864ull;
constexpr size_t OFF_R2 = OFF_R1 + SZ_R1;
constexpr size_t SZ_R2 = 2048ull * 73728;
constexpr size_t OFF_ZS = OFF_R2 + SZ_R2;
constexpr size_t OFF_GB = OFF_ZS + 8192ull * 1024 * 2;
constexpr size_t OFF_GL = OFF_GB + 8192ull * 32 * 4;
constexpr size_t OFF_BAR = OFF_GL + 8192;
constexpr size_t WS_END = OFF_BAR + 16384;
constexpr size_t CL_STRIDE = 73728, CL_WN = 0, CL_QG = 16384, CL_KD = 32768, CL_AT = 49152, CL_U = 57344;
constexpr size_t A_QB = 0;
constexpr size_t A_KS = A_QB + 8192ull * 1024 * 2;
constexpr size_t A_KP = A_KS + 2ull * 8 * 2304 * 128 * 2;
constexpr size_t A_VTS = A_KP + 16ull * 8 * 256 * 128 * 2;
constexpr size_t A_VTP = A_VTS + 2ull * 8 * 128 * 2304 * 2;
constexpr int LDS_BYTES = 147456;
constexpr unsigned DUP_MASK = 0x00000u;
constexpr float EPSF = 1e-6f;

struct Params {
    const float *x_prompt, *x_sample, *state_a, *cache_k, *cache_v, *c, *c_ctx, *w_mod, *b_mod, *norm_g, *ffn_wg, *ffn_wu, *ffn_wd, *a_w_in, *a_conv, *a_A_log, *a_dt_bias,
        *a_norm_g, *a_w_out, *b_w_qkv, *b_lam, *b_norm_g, *b_w_out, *c_w_pool, *c_scale, *final_g;
    float* out;
    unsigned char* ws;
    int ph_begin, ph_end;
};

DI int opq_tid() { const int w = __builtin_amdgcn_readfirstlane((int)threadIdx.x >> 6); const int l = __builtin_amdgcn_mbcnt_hi(~0u, __builtin_amdgcn_mbcnt_lo(~0u, 0u));
    int t = (w << 6) | l; asm volatile("" : "+v"(t)); return t; }
DI int opq_bid() { int t = blockIdx.x; asm volatile("" : "+s"(t)); return t; }
DI int opq_gdim() { int t = gridDim.x; asm volatile("" : "+s"(t)); return t; }
typedef __bf16 hwbf16x2 __attribute__((ext_vector_type(2)));
DI unsigned cvt_pk_bf16(float lo, float hi) { f32x2 v = {lo, hi}; hwbf16x2 b = __builtin_convertvector(v, hwbf16x2); return __builtin_bit_cast(unsigned, b); }
DI bf16_t to_bf16(float v) { return (bf16_t)(cvt_pk_bf16(v, v) & 0xffffu); }
DI float bf16_to_f(bf16_t b) { return __uint_as_float(((unsigned)b) << 16); }
DI int opq_lane() { int l = __builtin_amdgcn_mbcnt_hi(~0u, __builtin_amdgcn_mbcnt_lo(~0u, 0u)); asm volatile("" : "+v"(l)); return l; }
DI float shfl_lane(float v, int src) { return __int_as_float(__builtin_amdgcn_ds_bpermute(src << 2, __float_as_int(v))); }
DI float wave_sum(float v) {
    const int l = opq_lane();
#pragma unroll
    for (int o = 1; o < 64; o <<= 1) v += shfl_lane(v, l ^ o);
    return v;
}
DI float silu_f(float x) { return x * __builtin_amdgcn_rcpf(1.0f + __expf(-x)); }
DI float sigmoid_f(float x) { return 1.0f / (1.0f + expf(-x)); }
DI float softplus_f(float x) { return fmaxf(x, 0.f) + log1pf(expf(-fabsf(x))); }
#define LDSBAR() do { asm volatile("s_waitcnt lgkmcnt(0)" ::: "memory"); __builtin_amdgcn_s_barrier(); asm volatile("" ::: "memory"); } while (0)
DI int frag128(int row, int k) { return ((((row >> 5) * 8 + (k >> 4)) * 64 + ((k >> 3) & 1) * 32 + (row & 31)) << 3) + (k & 7); }
DI int frag64(int row, int k) { return ((((row >> 5) * 4 + (k >> 4)) * 64 + ((k >> 3) & 1) * 32 + (row & 31)) << 3) + (k & 7); }
template <int OFF> DI void gld16(u32x4& d, const void* p) { asm volatile("global_load_dwordx4 %0, %1, off offset:%2" : "=v"(d) : "v"(p), "n"(OFF) : "memory"); }
DI void gld4(float& d, const void* p) { asm volatile("global_load_dword %0, %1, off" : "=v"(d) : "v"(p) : "memory"); }
DI int crow(int reg, int h) { return (reg & 3) + 8 * (reg >> 2) + 4 * h; }
DI int row_cond(int r) { return r < 4096 ? 0 : 1 + ((r - 4096) >> 11); }

namespace pg8 {
constexpr int BM = 256, BK = 64, HALF = 128, HTB = HALF * BK * 2, STAGE_BYTES = 8 * HTB;
DI int lds_byte(int r, int c) { const int st = (r >> 4) * 2 + (c >> 5), rr = r & 15, cc = c & 31, ob = rr * 64 + cc * 2; return st * 1024 + (ob ^ (((ob >> 9) & 1) << 5)); }
DI void stage_rc(int b, int& R, int& C) { const int st = b / 1024, sb = b % 1024, swz = sb ^ (((sb >> 9) & 1) << 5); R = (st >> 1) * 16 + swz / 64; C = (st & 1) * 32 + (swz % 64) / 2; }
DI int perm32(int rho) { const int n = rho >> 4, i = rho & 15; return 8 * (i >> 2) + 4 * n + (i & 3); }
struct Unit { int pm, pn, ka, kb; };
struct Gemm { const bf16_t* A; const bf16_t* Bt; int lda, ldb, nt; };
struct Sched {
    int nM, nNv, nwg, G, c, nS, kper, apn;
    DI void init(int nM_, int nN_, int nS_, int kper_, int apn_, int G_, int c_) { nM = nM_; nNv = nN_ * nS_; nS = nS_; kper = kper_; apn = apn_; nwg = nM * nNv; G = G_; c = c_; }
    DI bool next(int i, Unit& u) const {
        const long L = (long)i * G + c; if (L >= nwg) return false;
        int wgid = (int)L; { const int q = nwg / 8, r = nwg % 8, xcd = wgid % 8, off = wgid / 8; wgid = (xcd < r ? xcd * (q + 1) : r * (q + 1) + (xcd - r) * q) + off; }
        const int nig = 8 * nNv, gid = wgid / nig, fm = gid * 8, gsz = (nM - fm) < 8 ? (nM - fm) : 8;
        u.pm = fm + ((wgid % nig) % gsz); const int pnv = (wgid % nig) / gsz;
        u.pn = pnv / nS; const int ks = pnv % nS; u.ka = ks * kper + u.pn * apn; u.kb = ks * kper; return true;
    }
};

struct EpiF32 {
    static constexpr bool PERM = false;
    float* C; int ldc;
    DI void operator()(const f32x4 (&acc)[2][2][4][2], const Unit& u, int wr, int wc, int fr, int fq) const {
        const int row0 = u.pm * BM + wr * 64 + fr, col0 = u.pn * BM + wc * 32 + 4 * fq;
#pragma unroll
        for (int ai = 0; ai < 2; ++ai)
#pragma unroll
            for (int m = 0; m < 4; ++m) { float* rowp = C + (size_t)(row0 + ai * HALF + m * 16) * ldc + col0;
#pragma unroll
                for (int bj = 0; bj < 2; ++bj)
#pragma unroll
                    for (int n = 0; n < 2; ++n) STG(f32x4, rowp + bj * HALF + n * 16) = acc[ai][bj][m][n]; }
    }
};
struct EpiSwiglu {
    static constexpr bool PERM = true;
    bf16_t* O;
    DI void operator()(const f32x4 (&acc)[2][2][4][2], const Unit& u, int wr, int wc, int fr, int fq) const {
        const int row0 = u.pm * BM + wr * 64 + fr, col0 = u.pn * 128 + wc * 32 + 8 * fq;
#pragma unroll
        for (int ai = 0; ai < 2; ++ai)
#pragma unroll
            for (int m = 0; m < 4; ++m) { bf16_t* rowp = O + (size_t)(row0 + ai * HALF + m * 16) * 2816 + col0;
                float v[8];
#pragma unroll
                for (int n = 0; n < 2; ++n)
#pragma unroll
                    for (int j = 0; j < 4; ++j) v[n * 4 + j] = silu_f(acc[ai][0][m][n][j]) * acc[ai][1][m][n][j];
                u32x4 w; w.x = cvt_pk_bf16(v[0], v[1]); w.y = cvt_pk_bf16(v[2], v[3]); w.z = cvt_pk_bf16(v[4], v[5]); w.w = cvt_pk_bf16(v[6], v[7]);
                STG(u32x4, rowp) = w; }
    }
};
struct EpiResid {
    static constexpr bool PERM = true;
    bf16_t* PB; const float* gate; const float* colscale; float cf;
    DI void operator()(const f32x4 (&acc)[2][2][4][2], const Unit& u, int wr, int wc, int fr, int fq) const {
        const int row0 = u.pm * BM + wr * 64 + fr, col0 = u.pn * BM + wc * 32 + 8 * fq;
        const int cond = u.pm < 16 ? 0 : (u.pm < 24 ? 1 : 2);
        bf16_t* P = PB + (u.kb ? (size_t)8388608 : (size_t)0);
        f32x4 gv[2][2];
#pragma unroll
        for (int bj = 0; bj < 2; ++bj)
#pragma unroll
            for (int n = 0; n < 2; ++n) { const int cc = col0 + bj * HALF + n * 4; f32x4 g = LDG(f32x4, gate + cond * 9216 + cc) * cf;
                if (colscale) g = g * LDG(f32x4, colscale + cc); gv[bj][n] = g; }
#pragma unroll
        for (int ai = 0; ai < 2; ++ai)
#pragma unroll
            for (int m = 0; m < 4; ++m) { bf16_t* rowp = P + (size_t)(row0 + ai * HALF + m * 16) * 1024 + col0;
#pragma unroll
                for (int bj = 0; bj < 2; ++bj) { const f32x4 v0 = acc[ai][bj][m][0] * gv[bj][0], v1 = acc[ai][bj][m][1] * gv[bj][1];
                    u32x4 w; w.x = cvt_pk_bf16(v0[0], v0[1]); w.y = cvt_pk_bf16(v0[2], v0[3]); w.z = cvt_pk_bf16(v1[0], v1[1]); w.w = cvt_pk_bf16(v1[2], v1[3]);
                    STG(u32x4, rowp + bj * HALF) = w; } }
    }
};

template <class Epi>
DI void gemm_phase(LAS unsigned char* lds, const Gemm g, const Sched& S, const Epi& E) {
    const int tid = opq_tid(), wid = __builtin_amdgcn_readfirstlane(tid >> 6), lane = tid & 63, wr = wid >> 2, wc = wid & 3, fr = lane & 15, fq = lane >> 4;
    const int nt = g.nt;
    unsigned voffA[2], voffB[2];
#pragma unroll
    for (int i = 0; i < 2; ++i) { int R, C; stage_rc(tid * 16 + i * 8192, R, C); const int Rb = Epi::PERM ? ((R & ~31) + perm32(R & 31)) : R;
        voffA[i] = (unsigned)(R * g.lda + C) * 2u; voffB[i] = (unsigned)(Rb * g.ldb + C) * 2u; }
    const size_t kstep = (size_t)(BK * 2);
    const size_t hstepA = (size_t)HALF * g.lda * 2, hstepB = (size_t)HALF * g.ldb * 2;
    const unsigned ldsw = (unsigned)wid * 1024u;
    const int aoff = lds_byte(wr * 64 + fr, fq * 8), boff = lds_byte(wc * 32 + fr, fq * 8);
#define PG8_SA(b, h) (((b) * 2 + (h)) * HTB)
#define PG8_SB(b, h) ((4 + (b) * 2 + (h)) * HTB)
#define PG8_STAGE(bufoff, gbase, voff) do { _Pragma("unroll") for (int _i = 0; _i < 2; ++_i) \
        __builtin_amdgcn_global_load_lds((const unsigned*)((const char*)(gbase) + (voff)[_i]), (LAS unsigned*)(lds + (bufoff) + ldsw + _i * 8192), 16, 0, 0); } while (0)
#define PG8_LDA(dst, b, h) do { _Pragma("unroll") for (int m = 0; m < 4; ++m) _Pragma("unroll") for (int k = 0; k < 2; ++k) dst[m][k] = *(const LAS bf16x8*)(lds + PG8_SA(b, h) + aoff + m * 2048 + k * 1024); } while (0)
#define PG8_LDB(dst, b, h) do { _Pragma("unroll") for (int n = 0; n < 2; ++n) _Pragma("unroll") for (int k = 0; k < 2; ++k) dst[n][k] = *(const LAS bf16x8*)(lds + PG8_SB(b, h) + boff + n * 2048 + k * 1024); } while (0)
#define PG8_MMA(ai, bj, At, Bt) do { __builtin_amdgcn_s_setprio(1); _Pragma("unroll") for (int m = 0; m < 4; ++m) _Pragma("unroll") for (int n = 0; n < 2; ++n) _Pragma("unroll") for (int k = 0; k < 2; ++k) \
        acc[ai][bj][m][n] = __builtin_amdgcn_mfma_f32_16x16x32_bf16(Bt[n][k], At[m][k], acc[ai][bj][m][n], 0, 0, 0); __builtin_amdgcn_s_setprio(0); } while (0)
#define PG8_WAIT_V(n) asm volatile("s_waitcnt vmcnt(" #n ")" ::: "memory")
#define PG8_WAIT_L(n) asm volatile("s_waitcnt lgkmcnt(" #n ")" ::: "memory")
#define PG8_BAR __builtin_amdgcn_s_barrier()
#define PG8_SCHED __builtin_amdgcn_sched_barrier(0)
    Unit cur, nxt; int ui = 0;
    if (!S.next(0, cur)) return;
    f32x4 acc[2][2][4][2];
#pragma unroll
    for (int a = 0; a < 2; ++a)
#pragma unroll
        for (int b = 0; b < 2; ++b)
#pragma unroll
            for (int m = 0; m < 4; ++m)
#pragma unroll
                for (int n = 0; n < 2; ++n) acc[a][b][m][n] = (f32x4){0.f, 0.f, 0.f, 0.f};
    bf16x8 At[4][2], B0[2][2], B1[2][2];
    const char* cA = (const char*)g.A + ((size_t)cur.pm * BM * g.lda + cur.ka) * 2; const char* cB = (const char*)g.Bt + ((size_t)cur.pn * BM * g.ldb + cur.kb) * 2;
    PG8_STAGE(PG8_SB(0, 0), cB, voffB); PG8_STAGE(PG8_SB(0, 1), cB + hstepB, voffB); PG8_STAGE(PG8_SA(0, 0), cA, voffA); PG8_STAGE(PG8_SA(0, 1), cA + hstepA, voffA);
    if (wr == 1) PG8_BAR;
    PG8_WAIT_V(2); PG8_BAR;
    PG8_STAGE(PG8_SB(1, 0), cB + kstep, voffB); PG8_STAGE(PG8_SA(1, 0), cA + kstep, voffA); PG8_STAGE(PG8_SB(1, 1), cB + hstepB + kstep, voffB);
    PG8_WAIT_V(6); PG8_BAR;
    for (;;) {
        const bool has_next = S.next(ui + 1, nxt);
        const char* nA = has_next ? (const char*)g.A + ((size_t)nxt.pm * BM * g.lda + nxt.ka) * 2 : cA; const char* nB = has_next ? (const char*)g.Bt + ((size_t)nxt.pn * BM * g.ldb + nxt.kb) * 2 : cB;
        for (int t = 0; t < nt; t += 2) {
            const bool last = (t == nt - 2);
            const char* a1 = cA + (size_t)(t + 1) * kstep;
            const char* a2 = last ? nA : cA + (size_t)(t + 2) * kstep; const char* b2 = last ? nB : cB + (size_t)(t + 2) * kstep;
            const char* a3 = a2 + kstep; const char* b3 = b2 + kstep;
            PG8_LDB(B0, 0, 0); PG8_LDB(B1, 0, 1); PG8_SCHED; PG8_LDA(At, 0, 0); PG8_STAGE(PG8_SA(1, 1), a1 + hstepA, voffA);
            PG8_WAIT_V(8); PG8_WAIT_L(0); PG8_BAR; PG8_MMA(0, 0, At, B0); PG8_MMA(0, 1, At, B1); PG8_BAR; PG8_SCHED;
            PG8_LDA(At, 0, 1); PG8_STAGE(PG8_SB(0, 0), b2, voffB); PG8_STAGE(PG8_SB(0, 1), b2 + hstepB, voffB); PG8_STAGE(PG8_SA(0, 0), a2, voffA);
            PG8_WAIT_V(8); PG8_WAIT_L(0); PG8_BAR; PG8_MMA(1, 0, At, B0); PG8_MMA(1, 1, At, B1); PG8_BAR; PG8_SCHED;
            PG8_LDB(B0, 1, 0); PG8_LDB(B1, 1, 1); PG8_SCHED; PG8_LDA(At, 1, 0); PG8_STAGE(PG8_SA(0, 1), a2 + hstepA, voffA);
            PG8_WAIT_V(8); PG8_WAIT_L(0); PG8_BAR; PG8_MMA(0, 0, At, B0); PG8_MMA(0, 1, At, B1); PG8_BAR; PG8_SCHED;
            PG8_LDA(At, 1, 1); PG8_STAGE(PG8_SB(1, 0), b3, voffB); PG8_STAGE(PG8_SB(1, 1), b3 + hstepB, voffB); PG8_STAGE(PG8_SA(1, 0), a3, voffA);
            PG8_WAIT_V(8); PG8_WAIT_L(0); PG8_BAR; PG8_MMA(1, 0, At, B0); PG8_MMA(1, 1, At, B1); PG8_BAR; PG8_SCHED;
        }
        if (wr == 0) PG8_BAR;
        E(acc, cur, wr, wc, fr, fq);
        if (!has_next) break;
#pragma unroll
        for (int a = 0; a < 2; ++a)
#pragma unroll
            for (int b = 0; b < 2; ++b)
#pragma unroll
                for (int m = 0; m < 4; ++m)
#pragma unroll
                    for (int n = 0; n < 2; ++n) acc[a][b][m][n] = (f32x4){0.f, 0.f, 0.f, 0.f};
        cur = nxt; cA = nA; cB = nB; ++ui;
        if (wr == 1) PG8_BAR;
    }
    PG8_WAIT_V(0);
    PG8_BAR;
#undef PG8_SA
#undef PG8_SB
#undef PG8_STAGE
#undef PG8_LDA
#undef PG8_LDB
#undef PG8_MMA
#undef PG8_WAIT_V
#undef PG8_WAIT_L
#undef PG8_BAR
#undef PG8_SCHED
}
}

template <class Epi>
DI void run_gemm(unsigned char* smem, const bf16_t* A, int lda, const bf16_t* Bt, int ldb, int nN, int nS, int kper, int apn, const Epi& E) {
    pg8::Gemm g; g.A = A; g.Bt = Bt; g.lda = lda; g.ldb = ldb; g.nt = kper / 64;
    pg8::Sched S; S.init(32, nN, nS, kper, apn, (int)opq_gdim(), (int)opq_bid());
    pg8::gemm_phase<Epi>((LAS unsigned char*)smem, g, S, E);
}

DI int rowmap(int n, int mode) { return mode == 0 ? n : ((n >> 7) * 256 + (n & 127) + (mode == 2 ? 128 : 0)); }
DI void tr_item(const float* W, int K, int N, bf16_t* WT, int mode, float* scr, int item, int lane) {
    const int nblk = N / 32, kb = item / nblk, nb = item % nblk, k0 = 64 * kb, n0 = 32 * nb;
    float wv[32];
#pragma unroll
    for (int i = 0; i < 32; ++i) wv[i] = LDG(float, W + (size_t)(k0 + 2 * i + (lane >> 5)) * N + n0 + (lane & 31));
#pragma unroll
    for (int i = 0; i < 32; ++i) scr[(2 * i + (lane >> 5)) * 33 + (lane & 31)] = wv[i];
    __builtin_amdgcn_fence(__ATOMIC_RELEASE, "wavefront"); __builtin_amdgcn_wave_barrier(); __builtin_amdgcn_fence(__ATOMIC_ACQUIRE, "wavefront");
    const int c = lane & 7;
#pragma unroll
    for (int j = 0; j < 4; ++j) { const int n = (lane >> 3) + 8 * j; const float* s = scr + (8 * c) * 33 + n;
        u32x4 o; o.x = cvt_pk_bf16(s[0 * 33], s[1 * 33]); o.y = cvt_pk_bf16(s[2 * 33], s[3 * 33]); o.z = cvt_pk_bf16(s[4 * 33], s[5 * 33]); o.w = cvt_pk_bf16(s[6 * 33], s[7 * 33]);
        STG(u32x4, WT + (size_t)rowmap(n0 + n, mode) * K + k0 + 8 * c) = o; }
    __builtin_amdgcn_fence(__ATOMIC_RELEASE, "wavefront"); __builtin_amdgcn_wave_barrier(); __builtin_amdgcn_fence(__ATOMIC_ACQUIRE, "wavefront");
}
DI void phase_convert_layer(const Params& p, unsigned char* smem, int L, int klo, int khi, int gw, int NGW) {
    const int lane = opq_tid() & 63, wave = opq_tid() >> 6;
    float* scr = (float*)smem + wave * (64 * 33);
    constexpr int I_F = 1408, I_L = 6 * I_F, I_IN = 16 * 129, I_SQ = 512, I_QKV = 1536, I_PL = 32;
    const int nL = I_L + (L == 1 ? I_QKV + I_SQ : (L == 2 ? 4 * I_PL : I_IN + I_SQ));
    if (khi > nL) khi = nL;
    for (int k = klo + gw; k < khi; k += NGW) {
        int r = k;
        if (r < I_L) { const int idx = 2 * L + r / (3 * I_F), q = r % (3 * I_F), which = q / I_F, item = q % I_F;
            if (which == 0) tr_item(p.ffn_wg + (size_t)idx * 1024 * 2816, 1024, 2816, (bf16_t*)(p.ws + OFF_WGU + idx * SZ_WGU1), 1, scr, item, lane);
            else if (which == 1) tr_item(p.ffn_wu + (size_t)idx * 1024 * 2816, 1024, 2816, (bf16_t*)(p.ws + OFF_WGU + idx * SZ_WGU1), 2, scr, item, lane);
            else tr_item(p.ffn_wd + (size_t)idx * 2816 * 1024, 2816, 1024, (bf16_t*)(p.ws + OFF_WD + idx * SZ_WD1), 0, scr, item, lane);
            continue; }
        r -= I_L;
        if (L == 1) { if (r < I_QKV) tr_item(p.b_w_qkv, 1024, 3072, (bf16_t*)(p.ws + OFF_WQKV), 0, scr, r, lane); else tr_item(p.b_w_out, 1024, 1024, (bf16_t*)(p.ws + OFF_WBO), 0, scr, r - I_QKV, lane); }
        else if (L == 2) { const int gI = r / I_PL; tr_item(p.c_w_pool + (size_t)gI * 65536, 256, 256, (bf16_t*)(p.ws + OFF_WPOOL) + (size_t)gI * 65536, 0, scr, r % I_PL, lane); }
        else { const int sl = L / 3;
            if (r < I_IN) tr_item(p.a_w_in + (size_t)sl * 1024 * 4128, 1024, 4128, (bf16_t*)(p.ws + OFF_WIN + sl * SZ_WIN1), 0, scr, r, lane);
            else tr_item(p.a_w_out + (size_t)sl * 1024 * 1024, 1024, 1024, (bf16_t*)(p.ws + OFF_WAO + sl * 2097152ull), 0, scr, r - I_IN, lane); }
    }
}
DI void phase_convert(const Params& p, unsigned char* smem) { phase_convert_layer(p, smem, 0, 0, 1 << 30, opq_bid() * 8 + (opq_tid() >> 6), opq_gdim() * 8); }
DI void convert_in_gemm_tail(const Params& p, unsigned char* smem, int layer, int part) {
    const int G = opq_gdim(), tail0 = 704 % G, bid = opq_bid();
    if (bid < tail0) return;
    const int gw = (bid - tail0) * 8 + (opq_tid() >> 6), NGW = (G - tail0) * 8;
    if (layer == 0 && part == 0) phase_convert_layer(p, smem, 1, 0, 3136, gw, NGW);
    else if (layer == 0) { phase_convert_layer(p, smem, 1, 3136, 4224, gw, NGW); phase_convert_layer(p, smem, 1, 8448, 10496, gw, NGW); }
    else if (layer == 1 && part == 0) phase_convert_layer(p, smem, 1, 4224, 8448, gw, NGW);
    else if (layer == 1) phase_convert_layer(p, smem, 3, 0, 3675, gw, NGW);
    else if (layer == 2 && part == 0) phase_convert_layer(p, smem, 3, 3675, 7350, gw, NGW);
    else if (layer == 2) phase_convert_layer(p, smem, 3, 7350, 11024, gw, NGW);
}
DI void convert_in_qkv_tail(const Params& p, unsigned char* smem) {
    const int G = opq_gdim(), tail0 = 384 % G, bid = opq_bid();
    if (G >= 384) { phase_convert_layer(p, smem, 2, 0, 1 << 30, bid * 8 + (opq_tid() >> 6), G * 8); return; }
    if (bid < tail0) return;
    phase_convert_layer(p, smem, 2, 0, 1 << 30, (bid - tail0) * 8 + (opq_tid() >> 6), (G - tail0) * 8);
}
DI void phase_modpart(const Params& p, unsigned char* smem) {
    float* sS = (float*)smem;
    float* sR = sS + 192;
    float* mpart = (float*)(p.ws + OFF_R1);
    const int t = opq_tid(), cgI = t & 255, kh = t >> 8;
    for (int task = opq_bid(); task < 576; task += opq_gdim()) {
        const int layer = task / 144, rem = task % 144, nc = rem / 16, kc = rem % 16;
        __syncthreads();
        if (t < 192) { const int cc = t / 64, kk = t % 64, k = kc * 64 + kk; const float v = cc == 0 ? p.c_ctx[k] : p.c[(cc - 1) * 1024 + k]; sS[t] = v / (1.0f + expf(-v)); }
        __syncthreads();
        f32x4 a0 = {0, 0, 0, 0}, a1 = a0, a2 = a0;
        const float* wp = p.w_mod + ((size_t)layer * 1024 + kc * 64 + kh * 32) * 9216 + nc * 1024 + cgI * 4;
#pragma unroll 8
        for (int i = 0; i < 32; ++i) { const f32x4 w = LDG(f32x4, wp + (size_t)i * 9216); const int kk = kh * 32 + i;
            a0 += w * sS[kk]; a1 += w * sS[64 + kk]; a2 += w * sS[128 + kk]; }
        if (kh == 1) { float* q = sR + cgI * 12; *(f32x4*)q = a0; *(f32x4*)(q + 4) = a1; *(f32x4*)(q + 8) = a2; }
        __syncthreads();
        if (kh == 0) { const float* q = sR + cgI * 12; a0 += *(const f32x4*)q; a1 += *(const f32x4*)(q + 4); a2 += *(const f32x4*)(q + 8);
            float* o = mpart + ((size_t)(kc * 4 + layer) * 3) * 9216 + nc * 1024 + cgI * 4;
            *(f32x4*)o = a0; *(f32x4*)(o + 9216) = a1; *(f32x4*)(o + 2 * 9216) = a2; }
    }
}
DI void phase_modreduce(const Params& p) {
    const float* mpart = (const float*)(p.ws + OFF_R1); float* mods = (float*)(p.ws + OFF_MODS);
    for (int i = opq_bid() * 512 + opq_tid(); i < 110592; i += opq_gdim() * 512) {
        const int layer = i / 27648, n = i % 9216; float s = p.b_mod[layer * 9216 + n];
#pragma unroll
        for (int kc = 0; kc < 16; ++kc) s += mpart[(size_t)kc * 110592 + i];
        mods[i] = s;
    }
}

DI void phase_norm(const Params& p, int mode, int nparts, const float* g, const float* modl, int jshift, int jscale) {
    const int lane = opq_tid() & 63, gw = opq_bid() * 8 + (opq_tid() >> 6), NGW = opq_gdim() * 8;
    float* X = (float*)(p.ws + OFF_X); bf16_t* H = (bf16_t*)(p.ws + OFF_H); float* HF = (float*)(p.ws + OFF_HF); const bf16_t* PB = (const bf16_t*)(p.ws + OFF_R1);
    for (int r0 = gw; r0 < 8192; r0 += 2 * NGW) {
        f32x4 v[2][4]; float ss[2] = {0.f, 0.f};
#pragma unroll
        for (int q = 0; q < 2; ++q) { const int r = r0 + q * NGW; if (r < 8192) {
            const float* src = mode == 1 ? (r < 4096 ? p.x_prompt + (size_t)r * 1024 : p.x_sample + (size_t)(r - 4096) * 1024) : X + (size_t)r * 1024;
#pragma unroll
            for (int j = 0; j < 4; ++j) { const int cc = lane * 4 + 256 * j; v[q][j] = LDG(f32x4, src + cc);
                if (nparts > 0) { const u32x2 w = LDG(u32x2, PB + (size_t)r * 1024 + cc); v[q][j] += (f32x4){__uint_as_float(w.x << 16), __uint_as_float(w.x & 0xffff0000u), __uint_as_float(w.y << 16), __uint_as_float(w.y & 0xffff0000u)}; }
                if (nparts > 1) { const u32x2 w = LDG(u32x2, PB + 8388608 + (size_t)r * 1024 + cc); v[q][j] += (f32x4){__uint_as_float(w.x << 16), __uint_as_float(w.x & 0xffff0000u), __uint_as_float(w.y << 16), __uint_as_float(w.y & 0xffff0000u)}; }
                ss[q] += v[q][j].x * v[q][j].x + v[q][j].y * v[q][j].y + v[q][j].z * v[q][j].z + v[q][j].w * v[q][j].w; } } }
#pragma unroll
        for (int q = 0; q < 2; ++q) { const int r = r0 + q * NGW; if (r < 8192) {
            const float rstd = rsqrtf(wave_sum(ss[q]) * (1.0f / 1024.f) + EPSF);
            const int cond = row_cond(r);
#pragma unroll
            for (int j = 0; j < 4; ++j) { const int cc = lane * 4 + 256 * j; const f32x4 gg = LDG(f32x4, g + cc);
                f32x4 y = v[q][j] * rstd * gg;
                if (mode != 3) { const f32x4 sc = LDG(f32x4, modl + cond * 9216 + jscale * 1024 + cc), sh = LDG(f32x4, modl + cond * 9216 + jshift * 1024 + cc);
                    y = y * (sc + 1.0f) + sh;
                    u32x2 w; w.x = cvt_pk_bf16(y.x, y.y); w.y = cvt_pk_bf16(y.z, y.w); STG(u32x2, H + (size_t)r * 1024 + cc) = w;
                    if (mode == 1 || nparts > 0) STG(f32x4, X + (size_t)r * 1024 + cc) = v[q][j];
                    if (mode == 2) STG(f32x4, HF + (size_t)r * 1024 + cc) = y;
                } else STG(f32x4, p.out + (size_t)r * 1024 + cc) = y; } } }
    }
}

DI void seq_of_row(int r, int& row0, int& pos, int& L) { if (r < 4096) { row0 = r & ~255; pos = r & 255; L = 256; } else { const int q = r - 4096; row0 = 4096 + (q & ~2047); pos = q & 2047; L = 2048; } }
DI void phase_dn_gates(const Params& p, int slot) {
    const int lane = opq_tid() & 63, gw = opq_bid() * 8 + (opq_tid() >> 6), NGW = opq_gdim() * 8;
    float* GB = (float*)(p.ws + OFF_GB);
    const bf16_t* H = (const bf16_t*)(p.ws + OFF_H); const bf16_t* WAB = (const bf16_t*)(p.ws + OFF_WIN + slot * SZ_WIN1) + (size_t)4096 * 1024;
    for (int task = gw; task < 512; task += NGW) {
        const int r0 = task * 16; f32x4 c0 = {0, 0, 0, 0}, c1 = c0;
        const bf16_t* ap = H + (size_t)(r0 + (lane & 15)) * 1024 + (lane >> 4) * 8; const bf16_t* bp = WAB + (size_t)(lane & 15) * 1024 + (lane >> 4) * 8;
#pragma unroll 8
        for (int ks = 0; ks < 32; ++ks) { const bf16x8 a = *(const bf16x8*)(ap + ks * 32), b0 = *(const bf16x8*)(bp + ks * 32), b1 = *(const bf16x8*)(bp + 16 * 1024 + ks * 32);
            c0 = __builtin_amdgcn_mfma_f32_16x16x32_bf16(a, b0, c0, 0, 0, 0); c1 = __builtin_amdgcn_mfma_f32_16x16x32_bf16(a, b1, c1, 0, 0, 0); }
        const int col = lane & 15, which = col >> 3, head = col & 7;
#pragma unroll
        for (int dir = 0; dir < 2; ++dir) { const float al = expf(p.a_A_log[slot * 16 + dir * 8 + head]), db = p.a_dt_bias[slot * 16 + dir * 8 + head];
#pragma unroll
            for (int j = 0; j < 4; ++j) { const float v = dir ? c1[j] : c0[j]; const float o = which == 0 ? -al * softplus_f(v + db) : sigmoid_f(v);
                GB[(size_t)(r0 + (lane >> 4) * 4 + j) * 32 + dir * 16 + col] = o; } }
    }
}
DI void cl_decode(int cp, int& row0, int& L, int& chunk, int& cpb, int& nch) { if (cp < 64) { row0 = (cp >> 2) * 256; L = 256; chunk = cp & 3; cpb = cp & ~3; nch = 4; } else { const int cs = cp - 64; row0 = 4096 + (cs >> 5) * 2048; L = 2048; chunk = cs & 31; cpb = 64 + (cs & ~31); nch = 32; } }
DI void phase_dn_chunk(const Params& p, unsigned char* smem, int slot) {
    float* Ks = (float*)smem; float* Qs = Ks + 64 * 129; float* Vs = Qs + 64 * 129; float* Lm0 = Vs + 64 * 129; float* Lm1 = Lm0 + 64 * 68; float* gcs = Lm1 + 64 * 68; float* bes = gcs + 128; float* egs = bes + 128;
    const float* PROJ = (const float*)(p.ws + OFF_R1); const float* GB = (const float*)(p.ws + OFF_GB); bf16_t* ZS = (bf16_t*)(p.ws + OFF_ZS);
    float* GL = (float*)(p.ws + OFF_GL); const float* cw = p.a_conv + (size_t)slot * 5 * 3072;
    for (int task = opq_bid(); task < 1024; task += opq_gdim()) {
        const int t = opq_tid(), lane = t & 63, wave = t >> 6, h = lane >> 5;
        const int head = task & 7, cp = task >> 3; int row0, L, chunk, cpb, nch; cl_decode(cp, row0, L, chunk, cpb, nch);
        unsigned char* rec0 = p.ws + OFF_R2 + (size_t)(((cpb + chunk) * 8 + head) * 2 + 0) * CL_STRIDE;
        unsigned char* rec1 = p.ws + OFF_R2 + (size_t)(((cpb + nch - 1 - chunk) * 8 + head) * 2 + 1) * CL_STRIDE;
        __syncthreads();
        {
            const int c = t & 127, i0 = (t >> 7) * 16, pos0 = 64 * chunk + i0;
#pragma unroll
            for (int tz = 0; tz < 3; ++tz) { const int cb = tz * 1024 + head * 128 + c; float x[20], w[5];
#pragma unroll
                for (int j = 0; j < 5; ++j) w[j] = LDG(float, cw + j * 3072 + cb);
#pragma unroll
                for (int m = 0; m < 20; ++m) { const int pp = pos0 - 2 + m; x[m] = (pp >= 0 && pp < L) ? LDG(float, PROJ + (size_t)(row0 + pp) * 4096 + cb) : 0.f; }
                float* dst = (tz == 0 ? Qs : (tz == 1 ? Ks : Vs)) + i0 * 129 + c;
#pragma unroll
                for (int k = 0; k < 16; ++k) { const float v = x[k] * w[0] + x[k + 1] * w[1] + x[k + 2] * w[2] + x[k + 3] * w[3] + x[k + 4] * w[4]; dst[k * 129] = silu_f(v); } }
            { const float* zr = PROJ + (size_t)(row0 + pos0) * 4096 + 3072 + head * 128 + c; bf16_t* zd = ZS + (size_t)(row0 + pos0) * 1024 + head * 128 + c; float z[16];
#pragma unroll
              for (int k = 0; k < 16; ++k) z[k] = LDG(float, zr + (size_t)k * 4096);
#pragma unroll
              for (int k = 0; k < 16; ++k) STG(bf16_t, zd + (size_t)k * 1024) = to_bf16(silu_f(z[k])); }
            if (t < 128) { const int d = t >> 6, io = d ? 63 - lane : lane; const size_t gi = (size_t)(row0 + 64 * chunk + io) * 32 + d * 16 + head;
                float s2 = LDG(float, GB + gi); bes[t] = LDG(float, GB + gi + 8);
#pragma unroll
                for (int o = 1; o < 64; o <<= 1) { const float u = shfl_lane(s2, lane >= o ? lane - o : lane); if (lane >= o) s2 += u; }
                gcs[t] = s2; egs[t] = __expf(s2);
                if (lane == 63) STG(float, GL + ((cpb + (d ? nch - 1 - chunk : chunk)) * 8 + head) * 2 + d) = __expf(s2); }
        }
        __syncthreads();
        {
            const int i = t >> 3, sg = (t & 7) * 16;
#pragma unroll
            for (int tz = 0; tz < 2; ++tz) { float* row = (tz == 0 ? Qs : Ks) + i * 129 + sg; float v[16]; float ss = 0.f;
#pragma unroll
                for (int k = 0; k < 16; ++k) { v[k] = row[k]; ss += v[k] * v[k]; }
                ss += shfl_lane(ss, lane ^ 1); ss += shfl_lane(ss, lane ^ 2); ss += shfl_lane(ss, lane ^ 4);
                float sc = rsqrtf(ss + EPSF); if (tz == 0) sc *= 0.08838834764831845f;
#pragma unroll
                for (int k = 0; k < 16; ++k) row[k] = v[k] * sc; }
        }
        __syncthreads();
        {
          const int pr = wave >> 2, ti = (wave >> 1) & 1, tj = wave & 1; const float* Xs = pr ? Qs : Ks;
          f32x16 acc; for (int i = 0; i < 16; ++i) acc[i] = 0.f;
          const float* ap = Xs + (32 * ti + (lane & 31)) * 129 + h; const float* bp = Ks + (32 * tj + (lane & 31)) * 129 + h;
#pragma unroll 8
          for (int s2 = 0; s2 < 64; ++s2) acc = __builtin_amdgcn_mfma_f32_32x32x2f32(ap[2 * s2], bp[2 * s2], acc, 0, 0, 0);
          const int j = 32 * tj + (lane & 31), jr = 63 - j; const float g0j = gcs[j], g1j = gcs[64 + jr];
          bf16_t* AT0 = (bf16_t*)(rec0 + CL_AT); bf16_t* AT1 = (bf16_t*)(rec1 + CL_AT);
#pragma unroll
          for (int r = 0; r < 16; ++r) { const int i = 32 * ti + crow(r, h), ir = 63 - i;
              const float d0 = __expf(fminf(gcs[i] - g0j, 0.f)), d1 = __expf(fminf(gcs[64 + ir] - g1j, 0.f));
              if (pr == 0) { if (i > j) Lm0[j * 68 + i] = bes[i] * acc[r] * d0; else if (i < j) Lm1[jr * 68 + ir] = bes[64 + ir] * acc[r] * d1; }
              else { STG(bf16_t, AT0 + frag64(i, j)) = to_bf16(i >= j ? acc[r] * d0 : 0.f); STG(bf16_t, AT1 + frag64(ir, jr)) = to_bf16(i <= j ? acc[r] * d1 : 0.f); } }
#pragma unroll 1
          for (int d = 0; d < 2; ++d) { unsigned* QG = (unsigned*)((d ? rec1 : rec0) + CL_QG); unsigned* KD = (unsigned*)((d ? rec1 : rec0) + CL_KD); const float gl = gcs[d * 64 + 63];
              for (int e = t; e < 4096; e += 512) { const int il = e >> 6, d2 = (e & 63) * 2, io = d ? 63 - il : il; const float f = egs[d * 64 + il]; STG(unsigned, QG + (frag128(il, d2) >> 1)) = cvt_pk_bf16(Qs[io * 129 + d2] * f, Qs[io * 129 + d2 + 1] * f); }
              for (int e = t; e < 4096; e += 512) { const int dd = e >> 5, i2 = (e & 31) * 2, ia = d ? 63 - i2 : i2, ib = d ? 62 - i2 : i2 + 1;
                  STG(unsigned, KD + (frag64(dd, i2) >> 1)) = cvt_pk_bf16(Ks[ia * 129 + dd] * __expf(gl - gcs[d * 64 + i2]), Ks[ib * 129 + dd] * __expf(gl - gcs[d * 64 + i2 + 1])); } } }
        __syncthreads();
        {
            const int d = t >> 8, c = t & 255; int zoff; asm volatile("v_mov_b32 %0, 0" : "=v"(zoff));
            const float* LmT = (d ? Lm1 : Lm0) + zoff; const float* be = bes + d * 64 + zoff; const float* eg = egs + d * 64 + zoff;
            const float* src = c < 128 ? Vs + c : Ks + (c - 128); const int rs = d ? -129 : 129; src += d ? 63 * 129 : 0;
            f32x2 xv[32];
#pragma unroll
            for (int i = 0; i < 64; ++i) { const float v = src[i * rs] * be[i] * (c < 128 ? 1.0f : eg[i]); if (i & 1) xv[i >> 1].y = v; else xv[i >> 1].x = v; }
#pragma unroll
            for (int j = 0; j < 63; ++j) { const float xj = (j & 1) ? xv[j >> 1].y : xv[j >> 1].x; const int lj = __float_as_int(LmT[j * 68 + lane]);
#pragma unroll
                for (int i2 = (j + 1) / 2; i2 < 32; ++i2) {
                    if (2 * i2 > j) { f32x2 l; l.x = __int_as_float(__builtin_amdgcn_readlane(lj, 2 * i2)); l.y = __int_as_float(__builtin_amdgcn_readlane(lj, 2 * i2 + 1)); xv[i2] -= l * xj; }
                    else xv[i2].y -= __int_as_float(__builtin_amdgcn_readlane(lj, 2 * i2 + 1)) * xj; } }
            unsigned char* rec = d ? rec1 : rec0;
            if (c < 128) {
#pragma unroll
                for (int rt2 = 0; rt2 < 2; ++rt2)
#pragma unroll
                    for (int h2 = 0; h2 < 2; ++h2) { u32x4* dq = (u32x4*)(rec + CL_U) + (((c >> 5) * 2 + rt2) * 2) * 64 + h2 * 32 + (c & 31);
#pragma unroll
                        for (int half = 0; half < 2; ++half) { u32x4 w;
#pragma unroll
                            for (int dd = 0; dd < 4; ++dd) { const int g = 2 * half + (dd >> 1), ii = 32 * rt2 + 8 * g + 4 * h2 + 2 * (dd & 1); w[dd] = cvt_pk_bf16(xv[ii >> 1].x, xv[ii >> 1].y); }
                            STG(u32x4, dq + half * 64) = w; } } }
            else { bf16_t* dst = (bf16_t*)(rec + CL_WN); const int dk = c - 128;
#pragma unroll
                for (int i = 0; i < 32; ++i) { STG(bf16_t, dst + frag128(2 * i, dk)) = to_bf16(-xv[i].x); STG(bf16_t, dst + frag128(2 * i + 1, dk)) = to_bf16(-xv[i].y); } }
        }
    }
}
struct ScanTask { int b, head, dir, slice, cp0, nch, row0, L, samp; };
DI ScanTask scan_decode(int task) { ScanTask q;
    if (task < 128) { const int sc = task >> 2; q.slice = task & 3; q.b = sc >> 4; q.head = (sc >> 1) & 7; q.dir = sc & 1; q.cp0 = 64 + q.b * 32; q.nch = 32; q.row0 = 4096 + q.b * 2048; q.L = 2048; q.samp = 1; }
    else { const int pid = task - 128, pc = pid >> 2; q.slice = pid & 3; q.b = pc >> 4; q.head = (pc >> 1) & 7; q.dir = pc & 1; q.cp0 = q.b * 4; q.nch = 4; q.row0 = q.b * 256; q.L = 256; q.samp = 0; }
    return q; }
DI int scan_task_of(int G, int bid, int k) { return G == 256 ? (bid < 128 ? (k == 0 ? bid : 128 + 896 + bid) : 128 + (bid - 128) + 128 * k) : bid + k * G; }
DI void phase_dn_scan(const Params& p, unsigned char* smem, int slot) {
    bf16_t* St = (bf16_t*)smem;
    bf16_t* Vn = St + 32 * 136;
    const float* GL = (const float*)(p.ws + OFF_GL);
    float* ODIR = (float*)(p.ws + OFF_R1);
    const int t = opq_tid(), lane = t & 63, wave = __builtin_amdgcn_readfirstlane(t >> 6), h = lane >> 5, l31 = lane & 31;
    const int G = opq_gdim(), bid = opq_bid();
    const int ntask = (G == 256) ? (bid < 128 ? 2 : 7) : ((1152 - bid + G - 1) / G);
    u32x4 R0[12], R1[12]; float gl0, gl1;
    for (int k = 0; k < ntask; ++k) {
        const ScanTask tk = scan_decode(scan_task_of(G, bid, k)); const bool has_next = k + 1 < ntask; const ScanTask tn = scan_decode(scan_task_of(G, bid, has_next ? k + 1 : k));
        const int b = tk.b, head = tk.head, dir = tk.dir, slice = tk.slice, cp0 = tk.cp0, nch = tk.nch, row0 = tk.row0, L = tk.L; const bool samp = tk.samp != 0;
        f32x16 sacc; for (int i = 0; i < 16; ++i) sacc[i] = 0.f;
        const int rt = wave & 1, dkt = wave & 3;
        const unsigned char* rbase = p.ws + OFF_R2 + (size_t)((cp0 * 8 + head) * 2 + dir) * CL_STRIDE;
        const unsigned char* nrbase = p.ws + OFF_R2 + (size_t)((tn.cp0 * 8 + tn.head) * 2 + tn.dir) * CL_STRIDE;
        const unsigned aoffs = (unsigned)(wave < 2 ? CL_WN : CL_QG) + (unsigned)(((wave < 4 ? rt : 0) * 8) * 64 + lane) * 16u;
        const unsigned boffs = wave < 2 ? (unsigned)CL_U + (unsigned)(((slice * 2 + rt) * 2) * 64 + lane) * 16u
                             : (wave < 4 ? (unsigned)CL_AT + (unsigned)((rt * 4) * 64 + lane) * 16u : (unsigned)CL_KD + (unsigned)((dkt * 4) * 64 + lane) * 16u);
        const unsigned nboffs = wave < 2 ? (unsigned)CL_U + (unsigned)(((tn.slice * 2 + rt) * 2) * 64 + lane) * 16u
                             : (wave < 4 ? (unsigned)CL_AT + (unsigned)((rt * 4) * 64 + lane) * 16u : (unsigned)CL_KD + (unsigned)((dkt * 4) * 64 + lane) * 16u);
#define SCAN_SRC(cidx, off, noff) ((cidx) < nch ? rbase + (size_t)(cidx) * 16 * CL_STRIDE + (off) : (has_next ? nrbase + (size_t)((cidx) - nch) * 16 * CL_STRIDE + (noff) : rbase + (size_t)(nch - 1) * 16 * CL_STRIDE + (off)))
#define SCAN_ISSUE_A(R, cidx) do { const unsigned char* a_ = SCAN_SRC(cidx, aoffs, aoffs); const unsigned char* a2_ = a_ + 4096; \
            gld16<0>(R[0], a_); gld16<1024>(R[1], a_); gld16<2048>(R[2], a_); gld16<3072>(R[3], a_); gld16<0>(R[4], a2_); gld16<1024>(R[5], a2_); gld16<2048>(R[6], a2_); gld16<3072>(R[7], a2_); } while (0)
#define SCAN_ISSUE_B(R, gl, cidx) do { const unsigned char* b_ = SCAN_SRC(cidx, boffs, nboffs); \
            const int gi_ = (cidx) < nch ? ((cp0 + (cidx)) * 8 + head) * 2 + dir : (has_next ? ((tn.cp0 + (cidx) - nch) * 8 + tn.head) * 2 + tn.dir : ((cp0 + nch - 1) * 8 + head) * 2 + dir); \
            gld16<0>(R[8], b_); gld16<1024>(R[9], b_); gld16<2048>(R[10], b_); gld16<3072>(R[11], b_); gld4(gl, GL + gi_); } while (0)
#define SCAN_WAIT(N, R, gl) asm volatile("s_waitcnt vmcnt(" #N ")" : "+v"(R[0]), "+v"(R[1]), "+v"(R[2]), "+v"(R[3]), "+v"(R[4]), "+v"(R[5]), "+v"(R[6]), "+v"(R[7]), "+v"(R[8]), "+v"(R[9]), "+v"(R[10]), "+v"(R[11]), "+v"(gl) :: "memory")
#define SCAN_STEP(c, R, gl) do { \
            SCAN_WAIT(13, R, gl); \
            f32x16 acc; \
            if (wave < 4) { \
                if (wave < 2) { _Pragma("unroll") for (int j = 0; j < 4; ++j) { acc[2 * j] = __uint_as_float(R[8][j] << 16); acc[2 * j + 1] = __uint_as_float(R[8][j] & 0xffff0000u); acc[8 + 2 * j] = __uint_as_float(R[9][j] << 16); acc[8 + 2 * j + 1] = __uint_as_float(R[9][j] & 0xffff0000u); } } \
                else { _Pragma("unroll") for (int r = 0; r < 16; ++r) acc[r] = 0.f; } \
                _Pragma("unroll") for (int ks = 0; ks < 8; ++ks) { const bf16x8 bb = *(const bf16x8*)(St + l31 * 136 + ks * 16 + 8 * h); \
                    acc = __builtin_amdgcn_mfma_f32_32x32x16_bf16(__builtin_bit_cast(bf16x8, R[ks]), bb, acc, 0, 0, 0); } \
                if (wave < 2) { _Pragma("unroll") for (int gq = 0; gq < 4; ++gq) { u32x2 w; w.x = cvt_pk_bf16(acc[4 * gq], acc[4 * gq + 1]); w.y = cvt_pk_bf16(acc[4 * gq + 2], acc[4 * gq + 3]); \
                        *(u32x2*)(Vn + l31 * 72 + 32 * rt + 8 * gq + 4 * h) = w; } } \
            } \
            asm volatile("s_nop 7\n\ts_nop 7" ::: "memory"); \
            SCAN_ISSUE_A(R, (c) + 2); \
            LDSBAR(); \
            if (wave == 2 || wave == 3) { \
                _Pragma("unroll") for (int ks = 0; ks < 4; ++ks) { const bf16x8 bb = *(const bf16x8*)(Vn + l31 * 72 + ks * 16 + 8 * h); \
                    acc = __builtin_amdgcn_mfma_f32_32x32x16_bf16(__builtin_bit_cast(bf16x8, R[8 + ks]), bb, acc, 0, 0, 0); } \
                const unsigned voff = (unsigned)l31 + (unsigned)(dir ? 1 - h : h) * 4096u; \
                float* ob = ODIR + (size_t)dir * 8388608 + head * 128 + slice * 32 + (size_t)(row0 - (dir ? 4 : 0)) * 1024; \
                _Pragma("unroll") for (int r = 0; r < 16; ++r) { const int iu = 32 * rt + (r & 3) + 8 * (r >> 2); const int pu = dir ? L - 1 - (64 * (c) + iu) : 64 * (c) + iu; STG(float, ob + (size_t)pu * 1024 + voff) = acc[r]; } \
            } else if (wave >= 4) { \
                _Pragma("unroll") for (int r = 0; r < 16; ++r) sacc[r] *= gl; \
                _Pragma("unroll") for (int ks = 0; ks < 4; ++ks) { const bf16x8 bb = *(const bf16x8*)(Vn + l31 * 72 + ks * 16 + 8 * h); \
                    sacc = __builtin_amdgcn_mfma_f32_32x32x16_bf16(__builtin_bit_cast(bf16x8, R[8 + ks]), bb, sacc, 0, 0, 0); } \
                _Pragma("unroll") for (int gq = 0; gq < 4; ++gq) { u32x2 w; w.x = cvt_pk_bf16(sacc[4 * gq], sacc[4 * gq + 1]); w.y = cvt_pk_bf16(sacc[4 * gq + 2], sacc[4 * gq + 3]); \
                    *(u32x2*)(St + l31 * 136 + 32 * dkt + 8 * gq + 4 * h) = w; } \
            } \
            asm volatile("s_nop 7\n\ts_nop 7" ::: "memory"); \
            SCAN_ISSUE_B(R, gl, (c) + 2); \
            LDSBAR(); } while (0)
        __syncthreads();
        if (wave >= 4) {
            if (samp) { const float* s0 = p.state_a + ((((size_t)b * 2 + slot) * 2 + dir) * 8 + head) * 16384;
#pragma unroll
                for (int r = 0; r < 16; ++r) sacc[r] = LDG(float, s0 + (32 * dkt + crow(r, h)) * 128 + slice * 32 + l31); }
#pragma unroll
            for (int gq = 0; gq < 4; ++gq) { u32x2 w; w.x = cvt_pk_bf16(sacc[4 * gq], sacc[4 * gq + 1]); w.y = cvt_pk_bf16(sacc[4 * gq + 2], sacc[4 * gq + 3]);
                *(u32x2*)(St + l31 * 136 + 32 * dkt + 8 * gq + 4 * h) = w; } }
        __syncthreads();
        if (k == 0) { SCAN_ISSUE_A(R0, 0); SCAN_ISSUE_B(R0, gl0, 0); SCAN_ISSUE_A(R1, 1); SCAN_ISSUE_B(R1, gl1, 1); }
        for (int c = 0; c < nch; c += 2) { SCAN_STEP(c, R0, gl0); SCAN_STEP(c + 1, R1, gl1); }
        if (!samp && wave >= 4) { float* so = p.out + 8388608 + ((((size_t)b * 2 + slot) * 2 + dir) * 8 + head) * 16384;
#pragma unroll
            for (int r = 0; r < 16; ++r) STG(float, so + (32 * dkt + crow(r, h)) * 128 + slice * 32 + l31) = sacc[r]; }
        SCAN_WAIT(0, R0, gl0); SCAN_WAIT(0, R1, gl1);
#undef SCAN_SRC
#undef SCAN_ISSUE_A
#undef SCAN_ISSUE_B
#undef SCAN_WAIT
#undef SCAN_STEP
    }
}
DI void phase_dn_post(const Params& p, int slot) {
    const int lane = opq_tid() & 63, gw = opq_bid() * 8 + (opq_tid() >> 6), NGW = opq_gdim() * 8;
    const float* ODIR = (const float*)(p.ws + OFF_R1); const bf16_t* ZS = (const bf16_t*)(p.ws + OFF_ZS); bf16_t* H = (bf16_t*)(p.ws + OFF_H);
    const f32x4 g = LDG(f32x4, p.a_norm_g + slot * 128 + (lane & 31) * 4);
    for (int r0 = gw; r0 < 8192; r0 += 2 * NGW) {
        f32x4 o[2][4]; u32x2 z[2][4];
#pragma unroll
        for (int q = 0; q < 2; ++q) { const int r = r0 + q * NGW; if (r < 8192) {
#pragma unroll
            for (int j = 0; j < 4; ++j) { const size_t off = (size_t)r * 1024 + lane * 4 + 256 * j;
                o[q][j] = LDG(f32x4, ODIR + off) + LDG(f32x4, ODIR + 8388608 + off); z[q][j] = LDG(u32x2, ZS + off); } } }
#pragma unroll
        for (int q = 0; q < 2; ++q) { const int r = r0 + q * NGW; if (r < 8192) {
#pragma unroll
            for (int j = 0; j < 4; ++j) { const f32x4 v = o[q][j]; float ss = v.x * v.x + v.y * v.y + v.z * v.z + v.w * v.w;
#pragma unroll
                for (int m = 1; m < 32; m <<= 1) ss += shfl_lane(ss, lane ^ m);
                const float rstd = rsqrtf(ss * (1.0f / 128.f) + EPSF);
                const float z0 = __uint_as_float(z[q][j].x << 16), z1 = __uint_as_float(z[q][j].x & 0xffff0000u), z2 = __uint_as_float(z[q][j].y << 16), z3 = __uint_as_float(z[q][j].y & 0xffff0000u);
                u32x2 w; w.x = cvt_pk_bf16(v.x * rstd * g.x * z0, v.y * rstd * g.y * z1); w.y = cvt_pk_bf16(v.z * rstd * g.z * z2, v.w * rstd * g.w * z3);
                STG(u32x2, H + (size_t)r * 1024 + lane * 4 + 256 * j) = w; } } }
    }
}

DI void phase_at_prep(const Params& p, unsigned char* smem) {
    const int t = opq_tid(), lane = t & 63, gw = opq_bid() * 8 + (t >> 6), NGW = opq_gdim() * 8;
    const float* QKV = (const float*)(p.ws + OFF_R1); unsigned char* R2 = p.ws + OFF_R2;
    bf16_t* QB = (bf16_t*)(R2 + A_QB); bf16_t* KS = (bf16_t*)(R2 + A_KS); bf16_t* KP = (bf16_t*)(R2 + A_KP); bf16_t* VTS = (bf16_t*)(R2 + A_VTS); bf16_t* VTP = (bf16_t*)(R2 + A_VTP);
    float* ock = p.out + 16777216; float* ocv = p.out + 20971520;
    { const int st = lane >> 4, li = lane & 15, gq = li >> 2, cc = gq >> 1, half = gq & 1, f0 = 4 * (li & 3), d1 = cc * 64 + half * 32 + f0, d2 = d1 + 16;
      float invf[4];
#pragma unroll
      for (int k = 0; k < 4; ++k) invf[k] = exp2f(-(float)(f0 + k) * 0.8304820237218407f);
      for (int wt = gw; wt < 32768; wt += NGW) {
        const int T = wt * 4 + st, r = T >> 4, hq = T & 15, which = hq >> 3, head = hq & 7;
        const float* src = QKV + (size_t)r * 3072 + which * 1024 + head * 128;
        f32x4 x1 = LDG(f32x4, src + d1), x2 = LDG(f32x4, src + d2);
        bf16_t* dst;
        if (r >= 4096) { const int q = r - 4096, b = q >> 11, tk = q & 2047; const float pos = (float)(half ? (tk & 63) : (tk >> 6));
#pragma unroll
            for (int k = 0; k < 4; ++k) { const float ang = pos * invf[k]; const float n = rintf(ang * 0.15915494309189535f); float rr = fmaf(-n, 6.28125f, ang); rr = fmaf(-n, 1.9353071795864769e-3f, rr);
                const float sn = __sinf(rr), cs = __cosf(rr); const float o1 = x1[k] * cs - x2[k] * sn, o2 = x2[k] * cs + x1[k] * sn; x1[k] = o1; x2[k] = o2; }
            dst = which ? KS + ((size_t)(b * 8 + head) * 2304 + tk) * 128 : QB + (size_t)r * 1024 + head * 128;
        } else { const int b = r >> 8, tk = r & 255;
            dst = which ? KP + ((size_t)(b * 8 + head) * 256 + tk) * 128 : QB + (size_t)r * 1024 + head * 128;
            if (which) { float* o = ock + ((size_t)r * 8 + head) * 128; STG(f32x4, o + d1) = x1; STG(f32x4, o + d2) = x2; } }
        u32x2 w1, w2; w1.x = cvt_pk_bf16(x1[0], x1[1]); w1.y = cvt_pk_bf16(x1[2], x1[3]); w2.x = cvt_pk_bf16(x2[0], x2[1]); w2.y = cvt_pk_bf16(x2[2], x2[3]);
        STG(u32x2, dst + d1) = w1; STG(u32x2, dst + d2) = w2;
      } }
    for (int task = gw; task < 4096; task += NGW) { const int head = task & 7, pp = (task >> 3) & 255, b = task >> 11;
        const f32x2 v = *(const f32x2*)(p.cache_k + ((size_t)(b * 256 + pp) * 8 + head) * 128 + lane * 2);
        *(unsigned*)(KS + ((size_t)(b * 8 + head) * 2304 + 2048 + pp) * 128 + lane * 2) = cvt_pk_bf16(v.x, v.y); }
    float* Ts = (float*)smem;
    for (int task = opq_bid(); task < 1088; task += opq_gdim()) {
        __syncthreads();
        const int i = t >> 3, sg = (t & 7) * 16;
        int b, head, tile, nk; bf16_t* dstb; const float* srow; float* orow = nullptr;
        if (task < 576) { b = task / 288; const int rem = task % 288; head = rem / 36; tile = rem % 36; nk = 2304; dstb = VTS + (size_t)(b * 8 + head) * 128 * 2304;
            if (tile < 32) srow = QKV + (size_t)(4096 + b * 2048 + tile * 64 + i) * 3072 + 2048 + head * 128; else srow = p.cache_v + ((size_t)(b * 256 + (tile - 32) * 64 + i) * 8 + head) * 128; }
        else { const int q = task - 576; b = q >> 5; head = (q >> 2) & 7; tile = q & 3; nk = 256; dstb = VTP + (size_t)(b * 8 + head) * 128 * 256;
            srow = QKV + (size_t)(b * 256 + tile * 64 + i) * 3072 + 2048 + head * 128; orow = ocv + ((size_t)(b * 256 + tile * 64 + i) * 8 + head) * 128; }
#pragma unroll
        for (int q = 0; q < 4; ++q) { const f32x4 a = LDG(f32x4, srow + sg + q * 4); if (orow) STG(f32x4, orow + sg + q * 4) = a;
#pragma unroll
            for (int j = 0; j < 4; ++j) Ts[i * 129 + sg + q * 4 + j] = a[j]; }
        __syncthreads();
        { const int e = t >> 2, ck = (t & 3) * 16; u32x4 w0, w1; const float* s = Ts + ck * 129 + e;
          w0.x = cvt_pk_bf16(s[0], s[129]); w0.y = cvt_pk_bf16(s[2 * 129], s[3 * 129]); w0.z = cvt_pk_bf16(s[4 * 129], s[5 * 129]); w0.w = cvt_pk_bf16(s[6 * 129], s[7 * 129]);
          w1.x = cvt_pk_bf16(s[8 * 129], s[9 * 129]); w1.y = cvt_pk_bf16(s[10 * 129], s[11 * 129]); w1.z = cvt_pk_bf16(s[12 * 129], s[13 * 129]); w1.w = cvt_pk_bf16(s[14 * 129], s[15 * 129]);
          bf16_t* d = dstb + (size_t)e * nk + tile * 64 + ck; STG(u32x4, d) = w0; STG(u32x4, d + 8) = w1; }
    }
}
DI void phase_attn(const Params& p, unsigned char* smem, float lam_init) {
    const int t = opq_tid(), lane = t & 63, wave = __builtin_amdgcn_readfirstlane(t >> 6), h = lane >> 5, l31 = lane & 31, cc = wave >> 2, rq = wave & 3;
    unsigned char* R2 = p.ws + OFF_R2;
    const bf16_t* QB = (const bf16_t*)(R2 + A_QB); const bf16_t* KS = (const bf16_t*)(R2 + A_KS); const bf16_t* KP = (const bf16_t*)(R2 + A_KP);
    const bf16_t* VTS = (const bf16_t*)(R2 + A_VTS); const bf16_t* VTP = (const bf16_t*)(R2 + A_VTP); bf16_t* H = (bf16_t*)(p.ws + OFF_H);
    bf16_t* Kt = (bf16_t*)smem;
    bf16_t* Vt = Kt + 2 * 64 * 136;
    float* OX = (float*)smem;
    float d01 = 0.f, d23 = 0.f;
    for (int i = 0; i < 64; ++i) { d01 += p.b_lam[i] * p.b_lam[64 + i]; d23 += p.b_lam[128 + i] * p.b_lam[192 + i]; }
    const float lam = expf(d01) - expf(d23) + lam_init;
    const float sc2 = 0.125f * 1.4426950408889634f;
    for (int item = opq_bid(); item < 512; item += opq_gdim()) {
        int b, head, qrow0, nk; const bf16_t *Kb, *Vb;
        if (item < 256) { b = item >> 7; head = (item >> 4) & 7; qrow0 = 4096 + b * 2048 + (item & 15) * 128; nk = 2304; Kb = KS + (size_t)(b * 8 + head) * 2304 * 128; Vb = VTS + (size_t)(b * 8 + head) * 128 * 2304; }
        else { const int j = item - 256; b = j >> 4; head = (j >> 1) & 7; qrow0 = b * 256 + (j & 1) * 128; nk = 256; Kb = KP + (size_t)(b * 8 + head) * 256 * 128; Vb = VTP + (size_t)(b * 8 + head) * 128 * 256; }
        const int nkt = nk / 64, qrow = qrow0 + rq * 32 + l31;
        bf16x8 bq[4];
#pragma unroll
        for (int ks = 0; ks < 4; ++ks) bq[ks] = LDG(bf16x8, QB + (size_t)qrow * 1024 + head * 128 + cc * 64 + ks * 16 + 8 * h);
        f32x16 ao[4];
#pragma unroll
        for (int et = 0; et < 4; ++et) for (int i = 0; i < 16; ++i) ao[et][i] = 0.f;
        float mrun = -1e30f, lrun = 0.f;
        const int kkey = t >> 3, kch = t & 7;
        u32x4 kr[2], vr[2];
#pragma unroll
        for (int u = 0; u < 2; ++u) { const int id = t + u * 512, key = id >> 4, ch = id & 15; kr[u] = LDG(u32x4, Kb + (size_t)key * 128 + ch * 8);
            const int e = id >> 3, c8 = id & 7; vr[u] = LDG(u32x4, Vb + (size_t)e * nk + c8 * 8); }
        __syncthreads();
#pragma unroll
        for (int u = 0; u < 2; ++u) { const int id = t + u * 512, key = id >> 4, ch = id & 15; *(u32x4*)(Kt + key * 136 + ch * 8) = kr[u];
            const int e = id >> 3, c8 = id & 7; *(u32x4*)(Vt + e * 72 + c8 * 8) = vr[u]; }
        (void)kkey; (void)kch;
        for (int kt = 0; kt < nkt; ++kt) {
            LDSBAR();
            const int buf = kt & 1; const bool more = kt + 1 < nkt;
            if (more) {
#pragma unroll
                for (int u = 0; u < 2; ++u) { const int id = t + u * 512, key = id >> 4, ch = id & 15; kr[u] = LDG(u32x4, Kb + (size_t)((kt + 1) * 64 + key) * 128 + ch * 8);
                    const int e = id >> 3, c8 = id & 7; vr[u] = LDG(u32x4, Vb + (size_t)e * nk + (kt + 1) * 64 + c8 * 8); } }
            const bf16_t* Kc = Kt + buf * 64 * 136; const bf16_t* Vc = Vt + buf * 128 * 72;
            f32x16 as[2];
#pragma unroll
            for (int sub = 0; sub < 2; ++sub) { for (int i = 0; i < 16; ++i) as[sub][i] = 0.f;
#pragma unroll
                for (int ks = 0; ks < 4; ++ks) { const bf16x8 a = *(const bf16x8*)(Kc + (32 * sub + l31) * 136 + cc * 64 + ks * 16 + 8 * h);
                    as[sub] = __builtin_amdgcn_mfma_f32_32x32x16_bf16(a, bq[ks], as[sub], 0, 0, 0); } }
            float mx = -1e30f;
#pragma unroll
            for (int sub = 0; sub < 2; ++sub)
#pragma unroll
                for (int i = 0; i < 16; ++i) mx = fmaxf(mx, as[sub][i]);
            mx = fmaxf(mx, shfl_lane(mx, lane ^ 32)) * sc2;
            const float mnew = fmaxf(mrun, mx), alpha = __builtin_amdgcn_exp2f(mrun - mnew); mrun = mnew;
            float ls = 0.f;
#pragma unroll
            for (int sub = 0; sub < 2; ++sub)
#pragma unroll
                for (int i = 0; i < 16; ++i) { const float pv = __builtin_amdgcn_exp2f(as[sub][i] * sc2 - mnew); as[sub][i] = pv; ls += pv; }
            lrun = lrun * alpha + ls;
#pragma unroll
            for (int et = 0; et < 4; ++et)
#pragma unroll
                for (int i = 0; i < 16; ++i) ao[et][i] *= alpha;
            bf16x8 pf[2][2];
#pragma unroll
            for (int sub = 0; sub < 2; ++sub)
#pragma unroll
                for (int s = 0; s < 2; ++s) { u32x4 w; w.x = cvt_pk_bf16(as[sub][8 * s], as[sub][8 * s + 1]); w.y = cvt_pk_bf16(as[sub][8 * s + 2], as[sub][8 * s + 3]);
                    w.z = cvt_pk_bf16(as[sub][8 * s + 4], as[sub][8 * s + 5]); w.w = cvt_pk_bf16(as[sub][8 * s + 6], as[sub][8 * s + 7]); pf[sub][s] = __builtin_bit_cast(bf16x8, w); }
#pragma unroll
            for (int et = 0; et < 4; ++et)
#pragma unroll
                for (int sub = 0; sub < 2; ++sub)
#pragma unroll
                    for (int s = 0; s < 2; ++s) { const bf16_t* vp = Vc + (32 * et + l31) * 72 + 32 * sub + 16 * s + 4 * h;
                        const s16x4 lo = *(const s16x4*)vp, hi = *(const s16x4*)(vp + 8);
                        const bf16x8 a = __builtin_shufflevector(lo, hi, 0, 1, 2, 3, 4, 5, 6, 7);
                        ao[et] = __builtin_amdgcn_mfma_f32_32x32x16_bf16(a, pf[sub][s], ao[et], 0, 0, 0); }
            if (more) {
                bf16_t* Kn = Kt + (buf ^ 1) * 64 * 136; bf16_t* Vnx = Vt + (buf ^ 1) * 128 * 72;
#pragma unroll
                for (int u = 0; u < 2; ++u) { const int id = t + u * 512, key = id >> 4, ch = id & 15; *(u32x4*)(Kn + key * 136 + ch * 8) = kr[u];
                    const int e = id >> 3, c8 = id & 7; *(u32x4*)(Vnx + e * 72 + c8 * 8) = vr[u]; } }
        }
        const float ltot = lrun + shfl_lane(lrun, lane ^ 32); const float inv = 1.0f / ltot;
        __syncthreads();
        if (cc == 1) { const float f = -lam * inv;
#pragma unroll
            for (int et = 0; et < 4; ++et)
#pragma unroll
                for (int i = 0; i < 16; ++i) OX[((rq * 4 + et) * 16 + i) * 64 + lane] = ao[et][i] * f; }
        __syncthreads();
        if (cc == 0) { float ss = 0.f;
#pragma unroll
            for (int et = 0; et < 4; ++et)
#pragma unroll
                for (int i = 0; i < 16; ++i) { const float o = ao[et][i] * inv + OX[((rq * 4 + et) * 16 + i) * 64 + lane]; ao[et][i] = o; ss += o * o; }
            ss += shfl_lane(ss, lane ^ 32);
            const float rstd = rsqrtf(ss * (1.0f / 128.f) + EPSF) * (1.0f - lam_init);
            bf16_t* op = H + (size_t)qrow * 1024 + head * 128;
#pragma unroll
            for (int et = 0; et < 4; ++et)
#pragma unroll
                for (int gq = 0; gq < 4; ++gq) { const int e0 = 32 * et + 8 * gq + 4 * h; const f32x4 g = LDG(f32x4, p.b_norm_g + e0);
                    u32x2 w; w.x = cvt_pk_bf16(ao[et][4 * gq] * rstd * g.x, ao[et][4 * gq + 1] * rstd * g.y); w.y = cvt_pk_bf16(ao[et][4 * gq + 2] * rstd * g.z, ao[et][4 * gq + 3] * rstd * g.w);
                    STG(u32x2, op + e0) = w; } }
    }
}

DI void phase_pool(const Params& p) {
    const float* HF = (const float*)(p.ws + OFF_HF); bf16_t* H = (bf16_t*)(p.ws + OFF_H);
    for (int i = opq_bid() * 512 + opq_tid(); i < 8192 * 256; i += opq_gdim() * 512) {
        const int r = i >> 8, c4 = (i & 255) * 4, gI = c4 >> 8, hw = 1 << gI;
        int row0, pos, L; seq_of_row(r, row0, pos, L);
        const int lo = max(pos - hw, 0), hi = min(pos + hw, L);
        f32x4 s = {0, 0, 0, 0};
        for (int q = lo; q < hi; ++q) s += *(const f32x4*)(HF + (size_t)(row0 + q) * 1024 + c4);
        const f32x4 me = *(const f32x4*)(HF + (size_t)r * 1024 + c4);
        const float ic = 1.0f / (float)(hi - lo); s = s * ic - me;
        u32x2 w; w.x = cvt_pk_bf16(s.x, s.y); w.y = cvt_pk_bf16(s.z, s.w); *(u32x2*)(H + (size_t)r * 1024 + c4) = w;
    }
}


#define XB_TMO      128
#define XB_XCNT(j)  (256  + 64 * (j))
#define XB_XSUB(j)  (1280 + 64 * (j))
#define XB_XGEN(j)  (2304 + 64 * (j))
#define XB_TOP      3328
#define XB_TOPGEN   3392
#define XCD_BAR_WORDS 3456
#define XB_SPIN_CAP (1u << 20)
DI unsigned xb_ld(unsigned* p)              { return __hip_atomic_load(p, __ATOMIC_RELAXED, __HIP_MEMORY_SCOPE_AGENT); }
DI unsigned xb_add(unsigned* p, unsigned v) { return __hip_atomic_fetch_add(p, v, __ATOMIC_RELAXED, __HIP_MEMORY_SCOPE_AGENT); }
DI unsigned xb_xcc_id() { return (unsigned)__builtin_amdgcn_s_getreg((3 << 11) | 20) & 0xFu; }
#define XB_SPIN(cond, bar) do { unsigned _sp = 0; while (cond) { __builtin_amdgcn_s_sleep(1); \
    if ((++_sp & 255u) == 0u) { if (xb_ld(&(bar)[XB_TMO])) break; if (_sp > XB_SPIN_CAP) { atomicAdd(&(bar)[XB_TMO], 1u); break; } } } } while (0)
DI void xcd_barrier_complete(unsigned* bar, unsigned x, unsigned& nloc, unsigned& nx) {
    const unsigned G = gridDim.x;
    unsigned sum, cnt, mine, sp = 0u;
    for (;;) {
        sum = 0u; cnt = 0u; mine = 0u;
#pragma unroll
        for (unsigned j = 0; j < 16; ++j) { const unsigned c = xb_ld(&bar[XB_XCNT(j)]); sum += c; cnt += (c > 0u) ? 1u : 0u; mine = (j == x) ? c : mine; }
        if (sum == G) break;
        __builtin_amdgcn_s_sleep(1);
        if ((++sp & 255u) == 0u) { if (xb_ld(&bar[XB_TMO])) break; if (sp > XB_SPIN_CAP) { atomicAdd(&bar[XB_TMO], 1u); break; } }
    }
    nloc = mine > 0u ? mine : 1u; nx = cnt > 0u ? cnt : 1u;
}
DI void xcd_barrier(unsigned* bar, volatile LAS unsigned* st) {
    asm volatile("s_waitcnt vmcnt(0)" ::: "memory");
    __syncthreads();
    if (threadIdx.x == 0) {
        const unsigned x = xb_xcc_id();
        __builtin_amdgcn_s_waitcnt(0);
        unsigned nloc = st[0], nx = st[1];
        if (nloc == 0u) { xcd_barrier_complete(bar, x, nloc, nx); st[0] = nloc; st[1] = nx; }
        const unsigned old = xb_add(&bar[XB_XSUB(x)], 1u);
        const unsigned gen = old / nloc;
        if (old + 1u == (gen + 1u) * nloc) {
            __builtin_amdgcn_fence(__ATOMIC_RELEASE, "agent");
            asm volatile("s_waitcnt vmcnt(0)" ::: "memory");
            const unsigned og = xb_add(&bar[XB_TOP], 1u);
            const unsigned tg = og / nx;
            if (og + 1u == (tg + 1u) * nx) xb_add(&bar[XB_TOPGEN], 1u);
            else XB_SPIN(xb_ld(&bar[XB_TOPGEN]) == tg, bar);
            __builtin_amdgcn_fence(__ATOMIC_ACQUIRE, "agent");
            xb_add(&bar[XB_XGEN(x)], 1u);
            asm volatile("s_waitcnt vmcnt(0)" ::: "memory");
        } else {
            XB_SPIN(xb_ld(&bar[XB_XGEN(x)]) == gen, bar);
            __builtin_amdgcn_fence(__ATOMIC_ACQUIRE, "agent");
            asm volatile("s_waitcnt vmcnt(0)" ::: "memory");
        }
    }
    __syncthreads();
}

__shared__ Params s_params;
DI Params load_params() {
    Params q; const unsigned* src = (const unsigned*)&s_params; unsigned* dst = (unsigned*)&q;
#pragma unroll
    for (int i = 0; i < (int)(sizeof(Params) / 4); ++i) dst[i] = __builtin_amdgcn_readfirstlane(src[i]);
    return q;
}
__global__ void __launch_bounds__(512, 2) mega(Params pk) {
    extern __shared__ __attribute__((aligned(16))) unsigned char smem[];
    cg::grid_group grid = cg::this_grid();
    __shared__ uint4 xb_words;
    if (opq_tid() == 0) { s_params = pk; xb_words = make_uint4(0u, 0u, 0u, 0u); }
    if (blockIdx.x == 0) for (int i = threadIdx.x; i < XCD_BAR_WORDS; i += 512) ((unsigned*)(pk.ws + OFF_BAR))[i] = 0u;
    __syncthreads();
#define GSYNC() xcd_barrier((unsigned*)(load_params().ws + OFF_BAR), (volatile LAS unsigned*)&xb_words)
#define PHASE(ty, ...) do { { const Params p = load_params(); const float cfmul = 1.0f; (void)cfmul; __VA_ARGS__; } \
        if ((DUP_MASK >> (ty)) & 1) { GSYNC(); const Params p = load_params(); const float cfmul = 1.0f; (void)cfmul; __VA_ARGS__; } \
        if ((DUP_MASK >> 15) & 1) GSYNC(); \
        GSYNC(); } while (0)
#define WS_H ((bf16_t*)(p.ws + OFF_H))
#define WS_X ((float*)(p.ws + OFF_X))
#define WS_ACT ((bf16_t*)(p.ws + OFF_R2))
#define MODL ((const float*)(p.ws + OFF_MODS) + layer * 27648)
    { const Params p = load_params(); phase_convert(p, smem); phase_modpart(p, smem); if (DUP_MASK & 1) { phase_convert(p, smem); phase_modpart(p, smem); } }
    grid.sync();
    if (threadIdx.x == 0) (void)xb_add((unsigned*)(load_params().ws + OFF_BAR) + XB_XCNT(xb_xcc_id()), 1u);
    PHASE(1, phase_modreduce(p));
    for (int layer = 0; layer < 4; ++layer) {
        const int kind = layer % 3, slot = layer / 3;
        for (int sub = 0; sub < 3; ++sub) {
            const int j0 = sub * 3;
            const int nmode = (layer == 0 && sub == 0) ? 1 : ((sub == 1 && kind == 2) ? 2 : 0);
            const int nparts = (layer == 0 && sub == 0) ? 0 : ((sub == 2 && kind == 2) ? 1 : 2);
            PHASE(2, phase_norm(p, nmode, cfmul != 0.f ? nparts : 0, p.norm_g + (layer * 3 + sub) * 1024, MODL, j0, j0 + 1));
            if (sub != 1) {
                const int idx = layer * 2 + (sub >> 1);
                PHASE(3, { pg8::EpiSwiglu E; E.O = WS_ACT; run_gemm(smem, WS_H, 1024, (const bf16_t*)(p.ws + OFF_WGU + idx * SZ_WGU1), 1024, 22, 1, 1024, 0, E); convert_in_gemm_tail(p, smem, layer, sub >> 1); });
                PHASE(4, { pg8::EpiResid E; E.PB = (bf16_t*)(p.ws + OFF_R1); E.gate = MODL + (j0 + 2) * 1024; E.colscale = nullptr; E.cf = 0.5f * cfmul;
                        run_gemm(smem, WS_ACT, 2816, (const bf16_t*)(p.ws + OFF_WD + idx * SZ_WD1), 2816, 4, 2, 1408, 0, E); });
            } else if (kind == 0) {
                PHASE(5, { pg8::EpiF32 E; E.C = (float*)(p.ws + OFF_R1); E.ldc = 4096; run_gemm(smem, WS_H, 1024, (const bf16_t*)(p.ws + OFF_WIN + slot * SZ_WIN1), 1024, 16, 1, 1024, 0, E); phase_dn_gates(p, slot); });
                PHASE(7, phase_dn_chunk(p, smem, slot));
                PHASE(8, phase_dn_scan(p, smem, slot));
                PHASE(9, phase_dn_post(p, slot));
                PHASE(10, { pg8::EpiResid E; E.PB = (bf16_t*)(p.ws + OFF_R1); E.gate = MODL + 5 * 1024; E.colscale = nullptr; E.cf = cfmul;
                        run_gemm(smem, WS_H, 1024, (const bf16_t*)(p.ws + OFF_WAO + slot * 2097152ull), 1024, 4, 2, 512, 0, E); });
            } else if (kind == 1) {
                PHASE(11, { pg8::EpiF32 E; E.C = (float*)(p.ws + OFF_R1); E.ldc = 3072; run_gemm(smem, WS_H, 1024, (const bf16_t*)(p.ws + OFF_WQKV), 1024, 12, 1, 1024, 0, E); convert_in_qkv_tail(p, smem); });
                PHASE(12, phase_at_prep(p, smem));
                PHASE(13, phase_attn(p, smem, 0.8f - 0.6f * 0.7408182206817179f));
                PHASE(10, { pg8::EpiResid E; E.PB = (bf16_t*)(p.ws + OFF_R1); E.gate = MODL + 5 * 1024; E.colscale = nullptr; E.cf = cfmul;
                        run_gemm(smem, WS_H, 1024, (const bf16_t*)(p.ws + OFF_WBO), 1024, 4, 2, 512, 0, E); });
            } else {
                PHASE(14, phase_pool(p));
                PHASE(10, { pg8::EpiResid E; E.PB = (bf16_t*)(p.ws + OFF_R1); E.gate = MODL + 5 * 1024; E.colscale = p.c_scale + slot * 1024; E.cf = cfmul;
                        run_gemm(smem, WS_H, 1024, (const bf16_t*)(p.ws + OFF_WPOOL), 256, 4, 1, 256, 256, E); });
            }
        }
    }
    { const Params p = load_params(); phase_norm(p, 3, 2, p.final_g, (const float*)(p.ws + OFF_MODS), 0, 0); }
#undef PHASE
}

extern "C" void kernel_launch(void* const* d_in, const int* in_sizes, int n_in, void* d_out, int out_size, void* d_ws, size_t ws_size, hipStream_t stream) {
    static int grid = 0;
    if (grid == 0) {
        if (n_in != 26 || ws_size < WS_END) { fprintf(stderr, "kernel_launch: unexpected n_in %d or workspace %zu < %zu\n", n_in, ws_size, (size_t)WS_END); grid = -1; return; }
        int dev = 0, cus = 0, per_cu = 0;
        hipGetDevice(&dev); hipDeviceGetAttribute(&cus, hipDeviceAttributeMultiprocessorCount, dev);
        if (hipFuncSetAttribute((const void*)mega, hipFuncAttributeMaxDynamicSharedMemorySize, LDS_BYTES) != hipSuccess) { fprintf(stderr, "kernel_launch: hipFuncSetAttribute failed\n"); grid = -1; return; }
        if (hipOccupancyMaxActiveBlocksPerMultiprocessor(&per_cu, (const void*)mega, 512, LDS_BYTES) != hipSuccess || per_cu < 1) { fprintf(stderr, "kernel_launch: occupancy query says %d\n", per_cu); per_cu = 1; }
        (void)hipGetLastError();
        grid = cus;
    }
    if (grid < 0) return;
    Params p; memset(&p, 0, sizeof(p));
    const float** f = (const float**)&p;
    for (int i = 0; i < 26; ++i) f[i] = (const float*)d_in[i];
    p.out = (float*)d_out; p.ws = (unsigned char*)d_ws; p.ph_begin = 0; p.ph_end = 1000;
    void* args[] = {&p};
    hipError_t e = hipLaunchCooperativeKernel((const void*)mega, dim3(grid), dim3(512), args, LDS_BYTES, stream);
    if (e != hipSuccess) fprintf(stderr, "cooperative launch failed: %s (grid %d)\n", hipGetErrorString(e), grid);
}
```
